# Optimizing an MI355X kernel written in HIP

```python
import math
import jax, jax.numpy as jnp
from jax import lax
import numpy as np

D_MODEL = 1024
BATCH = 8
SEQ = 2048
DEPTH = 2

HEAD_DIM = 64
A_WIDTH = D_MODEL // 2
A_HEADS = A_WIDTH // (2 * HEAD_DIM)
POOL_WINDOWS = (2, 4, 8, 16)
POOL_WIDTH = D_MODEL // 4
POOL_GROUPS = len(POOL_WINDOWS)
POOL_GROUP_DIM = POOL_WIDTH // POOL_GROUPS
C_WIDTH = D_MODEL // 4
C_HEADS = C_WIDTH // HEAD_DIM
DILATED_PAIRS = ((128, 1), (512, 4), (2048, 16))
IN_WIDTH = 3 * A_WIDTH + POOL_WIDTH + 3 * C_WIDTH
BLOCK = 128
ROPE_THETA = 10000.0
N_GROUPS = 4
EXPERTS_PER_GROUP = 8
TOP_K = 2
EXPERT_HIDDEN = D_MODEL // 4
N_MOD = 6
EPS = 1e-6

kernel_name = 'hymba_style_diffattn_pool_dilated_hmoe'


def rms_norm(x, g):
    xf = x.astype(jnp.float32)
    y = xf * lax.rsqrt(jnp.mean(xf * xf, axis=-1, keepdims=True) + EPS)
    return (y * g.astype(jnp.float32)).astype(x.dtype)


def rope_tables(seq, dim):
    inv = 1.0 / (ROPE_THETA ** (jnp.arange(0, dim, 2, dtype=jnp.float32) / dim))
    ang = jnp.arange(seq, dtype=jnp.float32)[:, None] * inv[None, :]
    ang = jnp.concatenate([ang, ang], axis=-1)
    return jnp.cos(ang), jnp.sin(ang)


def rope(t, cos, sin):
    half = t.shape[-1] // 2
    tf = t.astype(jnp.float32)
    rot = jnp.concatenate([-tf[..., half:], tf[..., :half]], axis=-1)
    return (tf * cos + rot * sin).astype(t.dtype)


def diff_attention(q, k, v, lam):
    B, H, _, S, dh = q.shape
    nb = S // BLOCK
    kpos = jnp.arange(S)
    scale = dh ** -0.5

    def block(i):
        qb = lax.dynamic_slice_in_dim(q, i * BLOCK, BLOCK, axis=3)
        s = jnp.einsum('bhmqd,bhmkd->bhmqk', qb, k, preferred_element_type=jnp.float32) * scale
        qpos = i * BLOCK + jnp.arange(BLOCK)
        s = jnp.where(kpos[None, :] <= qpos[:, None], s, -jnp.inf)
        p = jax.nn.softmax(s, axis=-1)
        a = p[:, :, 0] - lam * p[:, :, 1]
        return jnp.einsum('bhqk,bhkd->bhqd', a.astype(v.dtype), v)

    o = lax.map(block, jnp.arange(nb))
    return o.transpose(1, 2, 0, 3, 4).reshape(B, H, S, v.shape[-1])


def banded_causal_attention(q, k, v, w):
    lead = list(q.shape[:-2])
    L, dh = q.shape[-2], q.shape[-1]
    nb = -(-L // BLOCK)
    pad = nb * BLOCK - L
    padcfg = [(0, 0)] * len(lead) + [(0, pad), (0, 0)]

    def blocks(t):
        return jnp.pad(t, padcfg).reshape(*lead, nb, BLOCK, dh)

    def with_prev(t):
        prev = jnp.concatenate([jnp.zeros_like(t[..., :1, :, :]), t[..., :-1, :, :]], axis=-3)
        return jnp.concatenate([prev, t], axis=-2)

    qb = blocks(q)
    kb = with_prev(blocks(k))
    vb = with_prev(blocks(v))
    s = jnp.einsum('...nqd,...nkd->...nqk', qb, kb, preferred_element_type=jnp.float32) * (dh ** -0.5)
    a = jnp.arange(BLOCK)[:, None]
    b = jnp.arange(2 * BLOCK)[None, :]
    dist = a + BLOCK - b
    band = (dist >= 0) & (dist <= w)
    first = (jnp.arange(nb)[:, None, None] == 0) & (b[None] < BLOCK)
    mask = band[None] & jnp.logical_not(first)
    s = jnp.where(mask, s, -jnp.inf)
    lse = jax.nn.logsumexp(s, axis=-1)
    p = jnp.exp(s - lse[..., None])
    o = jnp.einsum('...nqk,...nkd->...nqd', p.astype(v.dtype), vb)
    o = o.reshape(*lead, nb * BLOCK, dh)[..., :L, :]
    lse = lse.reshape(*lead, nb * BLOCK)[..., :L]
    return o, lse


def dilated_branch(q, k, v, window, dil):
    B, H, S, dh = q.shape
    L = S // dil

    def sub(t):
        return t.reshape(B, H, L, dil, dh).transpose(0, 1, 3, 2, 4)

    o, lse = banded_causal_attention(sub(q), sub(k), sub(v), window // dil)
    o = o.transpose(0, 1, 3, 2, 4).reshape(B, H, S, dh)
    lse = lse.transpose(0, 1, 3, 2).reshape(B, H, S)
    return o, lse


def dilated_mixture(q, k, v):
    outs, lses = [], []
    for window, dil in DILATED_PAIRS:
        o, l = dilated_branch(q, k, v, window, dil)
        outs.append(o)
        lses.append(l)
    wts = jax.nn.softmax(jnp.stack(lses, axis=0), axis=0)
    out = jnp.sum(wts[..., None] * jnp.stack(outs, axis=0).astype(jnp.float32), axis=0)
    return out.astype(q.dtype)


def pool_mixer(u, w_pool, b_pool, scale):
    B, S, _ = u.shape
    uf = u.astype(jnp.float32).reshape(B, S, POOL_GROUPS, POOL_GROUP_DIM)
    cs = jnp.concatenate([jnp.zeros((B, 1, POOL_GROUPS, POOL_GROUP_DIM), jnp.float32),
                          jnp.cumsum(uf, axis=1)], axis=1)
    t = jnp.arange(S)
    win = jnp.array(POOL_WINDOWS, dtype=jnp.int32)
    lo = jnp.maximum(t[:, None] + 1 - win[None, :], 0)
    cnt = (t[:, None] + 1 - lo).astype(jnp.float32)
    gidx = jnp.arange(POOL_GROUPS)
    window_sum = cs[:, 1:] - cs[:, lo, gidx]
    d = window_sum / cnt[None, :, :, None] - uf
    y = jnp.einsum('bsgc,gce->bsge', d, w_pool.astype(jnp.float32)) + b_pool.astype(jnp.float32)
    return (y.reshape(B, S, POOL_WIDTH) * scale.astype(jnp.float32)).astype(u.dtype)


def hier_moe(h, w_rg, b_rg, w_re, b_re, w1, w3, w2):
    B, S, D = h.shape
    t = h.reshape(-1, D)
    gl = (t @ w_rg).astype(jnp.float32) + b_rg.astype(jnp.float32)
    gp = jax.nn.softmax(gl, axis=-1)
    g_idx = jnp.argmax(gl, axis=-1)
    g_w = jnp.take_along_axis(gp, g_idx[:, None], axis=1)[:, 0]
    el = jnp.einsum('td,gde->tge', t, w_re).astype(jnp.float32) + b_re.astype(jnp.float32)
    el_sel = jnp.take_along_axis(el, g_idx[:, None, None], axis=1)[:, 0]
    top_v, top_i = lax.top_k(el_sel, TOP_K)
    top_w = jax.nn.softmax(top_v, axis=-1) * g_w[:, None]
    e_w = jnp.sum(jax.nn.one_hot(top_i, EXPERTS_PER_GROUP, dtype=jnp.float32) * top_w[..., None], axis=1)
    combine = jax.nn.one_hot(g_idx, N_GROUPS, dtype=jnp.float32)[:, :, None] * e_w[:, None, :]
    y = jnp.zeros((t.shape[0], D), jnp.float32)
    for g in range(N_GROUPS):
        hid = jax.nn.silu(jnp.einsum('td,edf->tef', t, w1[g])) * jnp.einsum('td,edf->tef', t, w3[g])
        hid = hid * combine[:, g, :, None].astype(hid.dtype)
        y = y + jnp.einsum('tef,efd->td', hid, w2[g]).astype(jnp.float32)
    return y.reshape(B, S, D).astype(h.dtype)


def setup_inputs(seed: int = 0) -> dict:
    key = jax.random.key(seed)
    ks = jax.random.split(key, 24)
    L, D = DEPTH, D_MODEL
    G, E, F = N_GROUPS, EXPERTS_PER_GROUP, EXPERT_HIDDEN

    def nrm(k, shape, scale):
        return jax.random.normal(k, shape, jnp.float32) * scale

    return {
        'x': nrm(ks[0], (BATCH, SEQ, D), 1.0),
        'c': nrm(ks[1], (BATCH, D), 1.0),
        'w_mod': nrm(ks[2], (L, D, N_MOD * D), 0.5 * D ** -0.5),
        'b_mod': nrm(ks[3], (L, N_MOD * D), 0.01),
        'g_norm1': 1.0 + nrm(ks[4], (L, D), 0.1),
        'w_in': nrm(ks[5], (L, D, IN_WIDTH), D ** -0.5),
        'gq_a': 1.0 + nrm(ks[6], (L, HEAD_DIM), 0.1),
        'gk_a': 1.0 + nrm(ks[7], (L, HEAD_DIM), 0.1),
        'lam_a': nrm(ks[8], (L, 4, HEAD_DIM), 0.1),
        'g_sub_a': 1.0 + nrm(ks[9], (L, 2 * HEAD_DIM), 0.1),
        'w_pool': nrm(ks[10], (L, POOL_GROUPS, POOL_GROUP_DIM, POOL_GROUP_DIM), POOL_GROUP_DIM ** -0.5),
        'b_pool': nrm(ks[11], (L, POOL_GROUPS, POOL_GROUP_DIM), 0.01),
        'pool_scale': 1.0 + nrm(ks[12], (L, POOL_WIDTH), 0.1),
        'gq_c': 1.0 + nrm(ks[13], (L, HEAD_DIM), 0.1),
        'gk_c': 1.0 + nrm(ks[14], (L, HEAD_DIM), 0.1),
        'w_out': nrm(ks[15], (L, D, D), D ** -0.5),
        'g_norm2': 1.0 + nrm(ks[16], (L, D), 0.1),
        'w_rg': nrm(ks[17], (L, D, G), D ** -0.5),
        'b_rg': nrm(ks[18], (L, G), 0.01),
        'w_re': nrm(ks[19], (L, G, D, E), D ** -0.5),
        'b_re': nrm(ks[20], (L, G, E), 0.01),
        'w1': nrm(ks[21], (L, G, E, D, F), D ** -0.5),
        'w3': nrm(ks[22], (L, G, E, D, F), D ** -0.5),
        'w2': nrm(ks[23], (L, G, E, F, D), F ** -0.5),
    }


def reference(x, c, w_mod, b_mod, g_norm1, w_in, gq_a, gk_a, lam_a, g_sub_a, w_pool, b_pool,
              pool_scale, gq_c, gk_c, w_out, g_norm2, w_rg, b_rg, w_re, b_re, w1, w3, w2):
    B, S, D = x.shape
    cos, sin = rope_tables(S, HEAD_DIM)
    cond = jax.nn.silu(c)
    cuts = [A_WIDTH, 2 * A_WIDTH, 3 * A_WIDTH, 3 * A_WIDTH + POOL_WIDTH,
            3 * A_WIDTH + POOL_WIDTH + C_WIDTH, 3 * A_WIDTH + POOL_WIDTH + 2 * C_WIDTH]
    for l in range(DEPTH):
        mod = cond @ w_mod[l] + b_mod[l]
        sh1, sc1, ga1, sh2, sc2, ga2 = [m[:, None, :] for m in jnp.split(mod, N_MOD, axis=-1)]

        h = rms_norm(x, g_norm1[l]) * (1.0 + sc1) + sh1
        z = h @ w_in[l]
        qa, ka, va, ub, qc, kc, vc = jnp.split(z, cuts, axis=-1)

        qa = qa.reshape(B, S, A_HEADS, 2, HEAD_DIM).transpose(0, 2, 3, 1, 4)
        ka = ka.reshape(B, S, A_HEADS, 2, HEAD_DIM).transpose(0, 2, 3, 1, 4)
        va = va.reshape(B, S, A_HEADS, 2 * HEAD_DIM).transpose(0, 2, 1, 3)
        qa = rope(rms_norm(qa, gq_a[l]), cos, sin)
        ka = rope(rms_norm(ka, gk_a[l]), cos, sin)
        lam_init = 0.8 - 0.6 * math.exp(-0.3 * l)
        lp = lam_a[l].astype(jnp.float32)
        lam = jnp.exp(jnp.sum(lp[0] * lp[1])) - jnp.exp(jnp.sum(lp[2] * lp[3])) + lam_init
        ya = diff_attention(qa, ka, va, lam)
        ya = (rms_norm(ya, g_sub_a[l]) * (1.0 - lam_init)).transpose(0, 2, 1, 3).reshape(B, S, A_WIDTH)

        yb = pool_mixer(ub, w_pool[l], b_pool[l], pool_scale[l])

        qc = qc.reshape(B, S, C_HEADS, HEAD_DIM).transpose(0, 2, 1, 3)
        kc = kc.reshape(B, S, C_HEADS, HEAD_DIM).transpose(0, 2, 1, 3)
        vc = vc.reshape(B, S, C_HEADS, HEAD_DIM).transpose(0, 2, 1, 3)
        qc = rope(rms_norm(qc, gq_c[l]), cos, sin)
        kc = rope(rms_norm(kc, gk_c[l]), cos, sin)
        yc = dilated_mixture(qc, kc, vc).transpose(0, 2, 1, 3).reshape(B, S, C_WIDTH)

        y = jnp.concatenate([ya, yb, yc], axis=-1) @ w_out[l]
        x = x + ga1 * y

        h = rms_norm(x, g_norm2[l]) * (1.0 + sc2) + sh2
        x = x + ga2 * hier_moe(h, w_rg[l], b_rg[l], w_re[l], b_re[l], w1[l], w3[l], w2[l])
    return x
```

```cpp
#include <hip/hip_runtime.h>
#include <math.h>
#include <stdint.h>

constexpr int NB = 8, NS = 2048, ND = 1024, NT = NB * NS, NL = 2;
constexpr int INW = 2560, NMOD = 6144;
constexpr float EPS = 1e-6f;

__device__ const double ROPE_REV[32] = {
1.59154943091895345608e-01, 1.19349370211248861917e-01, 8.94994016088910132600e-02, 6.71150830052272551196e-02,
5.03292121044870352509e-02, 3.77415847174197710556e-02, 2.83021958306233986646e-02, 2.12236527647776604399e-02,
1.59154943091895338669e-02, 1.19349370211248861917e-02, 8.94994016088910236684e-03, 6.71150830052272533849e-03,
5.03292121044870369856e-03, 3.77415847174197719230e-03, 2.83021958306233986646e-03, 2.12236527647776621747e-03,
1.59154943091895334333e-03, 1.19349370211248848907e-03, 8.94994016088910128263e-04, 6.71150830052272490481e-04,
5.03292121044870326488e-04, 3.77415847174197686704e-04, 2.83021958306233954120e-04, 2.12236527647776605484e-04,
1.59154943091895323490e-04, 1.19349370211248848907e-04, 8.94994016088910182474e-05, 6.71150830052272544691e-05,
5.03292121044870353593e-05, 3.77415847174197700256e-05, 2.83021958306233960897e-05, 2.12236527647776591931e-05};

__device__ __forceinline__ float wave_sum(float v) {
#pragma unroll
    for (int o = 1; o < 64; o <<= 1) v += __shfl_xor(v, o);
    return v;
}
__device__ __forceinline__ float wave_max(float v) {
#pragma unroll
    for (int o = 1; o < 64; o <<= 1) v = fmaxf(v, __shfl_xor(v, o));
    return v;
}
__device__ __forceinline__ float block_sum256(float v, float* red) {
    v = wave_sum(v);
    __syncthreads();
    if ((threadIdx.x & 63) == 0) red[threadIdx.x >> 6] = v;
    __syncthreads();
    return red[0] + red[1] + red[2] + red[3];
}
__device__ __forceinline__ float block_max256(float v, float* red) {
    v = wave_max(v);
    __syncthreads();
    if ((threadIdx.x & 63) == 0) red[threadIdx.x >> 6] = v;
    __syncthreads();
    return fmaxf(fmaxf(red[0], red[1]), fmaxf(red[2], red[3]));
}

__global__ void __launch_bounds__(256) k_mod(const float* __restrict__ c, const float* __restrict__ w_mod, const float* __restrict__ b_mod, float* __restrict__ mod) {
    __shared__ float cond[NB * ND];
    for (int i = threadIdx.x; i < NB * ND; i += 256) { float v = c[i]; cond[i] = v / (1.f + expf(-v)); }
    __syncthreads();
    const int idx = blockIdx.x * 256 + threadIdx.x;
    const int l = idx / NMOD, j = idx % NMOD;
    float acc[NB];
#pragma unroll
    for (int b = 0; b < NB; ++b) acc[b] = 0.f;
    const float* w = w_mod + (size_t)l * ND * NMOD + j;
    for (int d = 0; d < ND; ++d) {
        const float wv = w[(size_t)d * NMOD];
#pragma unroll
        for (int b = 0; b < NB; ++b) acc[b] += cond[b * ND + d] * wv;
    }
#pragma unroll
    for (int b = 0; b < NB; ++b) mod[(size_t)(l * NB + b) * NMOD + j] = acc[b] + b_mod[l * NMOD + j];
}
__global__ void k_misc(const float* __restrict__ lam_a, float* __restrict__ lamv, float* __restrict__ cosT, float* __restrict__ sinT) {
    const int idx = blockIdx.x * 256 + threadIdx.x;
    if (idx < NS * 32) {
        const int t = idx >> 5, i = idx & 31;
        double r = (double)t * ROPE_REV[i];
        r = r - rint(r);
        const float rf = (float)r;
        cosT[idx] = __builtin_amdgcn_cosf(rf);
        sinT[idx] = __builtin_amdgcn_sinf(rf);
    }
    if (blockIdx.x == 0 && threadIdx.x < 64) {
        const int lane = threadIdx.x;
        for (int l = 0; l < NL; ++l) {
            const float* lp = lam_a + l * 256;
            const float a = wave_sum(lp[lane] * lp[64 + lane]);
            const float b = wave_sum(lp[128 + lane] * lp[192 + lane]);
            const float lam_init = 0.8f - 0.6f * expf(-0.3f * (float)l);
            if (lane == 0) { lamv[2 * l] = expf(a) - expf(b) + lam_init; lamv[2 * l + 1] = lam_init; }
        }
    }
}

__global__ void __launch_bounds__(256) k_ln(const float* __restrict__ x, const float* __restrict__ g, const float* __restrict__ modl, int sh_off, int sc_off, float* __restrict__ h) {
    const int row = blockIdx.x * 4 + (threadIdx.x >> 6), lane = threadIdx.x & 63;
    const int b = row / NS;
    const float4* xr = (const float4*)(x + (size_t)row * ND);
    float4 v[4]; float ss = 0.f;
#pragma unroll
    for (int j = 0; j < 4; ++j) { v[j] = xr[lane + 64 * j]; ss += v[j].x * v[j].x + v[j].y * v[j].y + v[j].z * v[j].z + v[j].w * v[j].w; }
    ss = wave_sum(ss);
    const float rstd = 1.0f / sqrtf(ss * (1.f / ND) + EPS);
    const float* mb = modl + (size_t)b * NMOD;
    float4* hr = (float4*)(h + (size_t)row * ND);
#pragma unroll
    for (int j = 0; j < 4; ++j) {
        const int d = (lane + 64 * j) * 4;
        const float4 gg = *(const float4*)(g + d), sc = *(const float4*)(mb + sc_off + d), sh = *(const float4*)(mb + sh_off + d);
        float4 o;
        o.x = v[j].x * rstd * gg.x * (1.f + sc.x) + sh.x;
        o.y = v[j].y * rstd * gg.y * (1.f + sc.y) + sh.y;
        o.z = v[j].z * rstd * gg.z * (1.f + sc.z) + sh.z;
        o.w = v[j].w * rstd * gg.w * (1.f + sc.w) + sh.w;
        hr[lane + 64 * j] = o;
    }
}

template <int EPI>
__global__ void __launch_bounds__(256) k_gemm(const float* __restrict__ A, const float* __restrict__ Bm, float* __restrict__ C, int M, int N, int K,
                                               const float* __restrict__ resid, const float* __restrict__ gate) {
    __shared__ float As[16][64 + 4];
    __shared__ float Bs[16][64];
    const int tid = threadIdx.x, tx = tid & 15, ty = tid >> 4;
    const int m0 = blockIdx.y * 64, n0 = blockIdx.x * 64;
    float acc[4][4];
#pragma unroll
    for (int i = 0; i < 4; ++i)
#pragma unroll
        for (int j = 0; j < 4; ++j) acc[i][j] = 0.f;
    for (int k0 = 0; k0 < K; k0 += 16) {
#pragma unroll
        for (int i = 0; i < 4; ++i) {
            const int idx = tid + i * 256;
            const int m = idx >> 4, k = idx & 15;
            As[k][m] = A[(size_t)(m0 + m) * K + k0 + k];
            const int kk = idx >> 6, n = idx & 63;
            Bs[kk][n] = Bm[(size_t)(k0 + kk) * N + n0 + n];
        }
        __syncthreads();
#pragma unroll
        for (int k = 0; k < 16; ++k) {
            float a[4], b[4];
#pragma unroll
            for (int i = 0; i < 4; ++i) a[i] = As[k][ty * 4 + i];
#pragma unroll
            for (int j = 0; j < 4; ++j) b[j] = Bs[k][tx * 4 + j];
#pragma unroll
            for (int i = 0; i < 4; ++i)
#pragma unroll
                for (int j = 0; j < 4; ++j) acc[i][j] += a[i] * b[j];
        }
        __syncthreads();
    }
#pragma unroll
    for (int i = 0; i < 4; ++i) {
        const int m = m0 + ty * 4 + i;
#pragma unroll
        for (int j = 0; j < 4; ++j) {
            const int n = n0 + tx * 4 + j;
            float v = acc[i][j];
            if (EPI == 1) v = resid[(size_t)m * N + n] + gate[(size_t)(m / NS) * NMOD + n] * v;
            C[(size_t)m * N + n] = v;
        }
    }
}

__global__ void __launch_bounds__(256) k_qkprep(float* __restrict__ z, const float* __restrict__ gq_a, const float* __restrict__ gk_a, const float* __restrict__ gq_c, const float* __restrict__ gk_c,
                                                 const float* __restrict__ cosT, const float* __restrict__ sinT) {
    const int w = blockIdx.x * 4 + (threadIdx.x >> 6), lane = threadIdx.x & 63;
    const int t = w / 24, ch = w % 24;
    int col; const float* gain;
    if (ch < 8) { col = ch * 64; gain = gq_a; }
    else if (ch < 16) { col = 512 + (ch - 8) * 64; gain = gk_a; }
    else if (ch < 20) { col = 1792 + (ch - 16) * 64; gain = gq_c; }
    else { col = 2048 + (ch - 20) * 64; gain = gk_c; }
    float* p = z + (size_t)t * INW + col + lane;
    const float v = *p;
    const float ss = wave_sum(v * v);
    const float n = v * (1.0f / sqrtf(ss * (1.f / 64.f) + EPS)) * gain[lane];
    const float partner = __shfl_xor(n, 32);
    const int pos = t % NS;
    const float c = cosT[pos * 32 + (lane & 31)], s = sinT[pos * 32 + (lane & 31)];
    *p = (lane < 32) ? (n * c - partner * s) : (n * c + partner * s);
}

__global__ void __launch_bounds__(256) k_diffattn(const float* __restrict__ z, const float* __restrict__ lamv, const float* __restrict__ gsub, float* __restrict__ ycat) {
    __shared__ float q[128];
    __shared__ float s0[NS], s1[NS];
    __shared__ float red[8];
    __shared__ float oh[256];
    const int tid = threadIdx.x;
    const int t = blockIdx.x % NS, h = (blockIdx.x / NS) % 4, b = blockIdx.x / (NS * 4);
    const float lam = lamv[0], omli = 1.0f - lamv[1];
    const size_t rowb = (size_t)b * NS;
    if (tid < 128) q[tid] = z[(rowb + t) * INW + h * 128 + tid];
    __syncthreads();
    float m0 = -INFINITY, m1 = -INFINITY;
    for (int k = tid; k <= t; k += 256) {
        const float* kr = z + (rowb + k) * INW + 512 + h * 128;
        float d0 = 0.f, d1 = 0.f;
        for (int d = 0; d < 64; ++d) { d0 += q[d] * kr[d]; d1 += q[64 + d] * kr[64 + d]; }
        d0 *= 0.125f; d1 *= 0.125f;
        s0[k] = d0; s1[k] = d1; m0 = fmaxf(m0, d0); m1 = fmaxf(m1, d1);
    }
    m0 = block_max256(m0, red);
    m1 = block_max256(m1, red);
    float l0 = 0.f, l1 = 0.f;
    for (int k = tid; k <= t; k += 256) {
        const float p0 = expf(s0[k] - m0), p1 = expf(s1[k] - m1);
        s0[k] = p0; s1[k] = p1; l0 += p0; l1 += p1;
    }
    l0 = block_sum256(l0, red);
    l1 = block_sum256(l1, red);
    __syncthreads();
    const float i0 = 1.0f / l0, i1 = lam / l1;
    const int dv = tid & 127, half = tid >> 7;
    float acc = 0.f;
    for (int k = half; k <= t; k += 2) {
        const float a = s0[k] * i0 - s1[k] * i1;
        acc += a * z[(rowb + k) * INW + 1024 + h * 128 + dv];
    }
    oh[tid] = acc;
    __syncthreads();
    float o = 0.f;
    if (tid < 128) o = oh[tid] + oh[tid + 128];
    const float ss = block_sum256(o * o, red);
    if (tid < 128) ycat[(rowb + t) * ND + h * 128 + tid] = o * (1.0f / sqrtf(ss * (1.f / 128.f) + EPS)) * gsub[tid] * omli;
}

__global__ void __launch_bounds__(256) k_pool(const float* __restrict__ z, const float* __restrict__ w_pool, const float* __restrict__ b_pool, const float* __restrict__ pool_scale, float* __restrict__ ycat) {
    __shared__ float dsh[256];
    const int tid = threadIdx.x, row = blockIdx.x, t = row % NS;
    const int g = tid >> 6, cch = tid & 63;
    const int win = 2 << g;
    const int lo = max(t + 1 - win, 0);
    float s = 0.f;
    for (int tt = lo; tt <= t; ++tt) s += z[(size_t)(row - t + tt) * INW + 1536 + tid];
    const float u = z[(size_t)row * INW + 1536 + tid];
    dsh[tid] = s / (float)(t + 1 - lo) - u;
    __syncthreads();
    float y = b_pool[g * 64 + cch];
    const float* w = w_pool + g * 4096 + cch;
    for (int c = 0; c < 64; ++c) y += dsh[g * 64 + c] * w[c * 64];
    ycat[(size_t)row * ND + 512 + tid] = y * pool_scale[tid];
}

__global__ void __launch_bounds__(256) k_dilated(const float* __restrict__ z, float* __restrict__ ycat) {
    __shared__ float esh[4][392];
    __shared__ int ksh[4][392];
    const int wv = threadIdx.x >> 6, lane = threadIdx.x & 63;
    const int w = blockIdx.x * 4 + wv;
    const int t = w % NS, h = (w / NS) % 4, b = w / (NS * 4);
    const size_t rowb = (size_t)b * NS;
    const float* qp = z + (rowb + t) * INW + 1792 + h * 64;
    float sc[7]; int kp[7];
    float mx = -INFINITY;
#pragma unroll
    for (int j = 0; j < 7; ++j) {
        const int idx = lane + 64 * j;
        sc[j] = -INFINITY; kp[j] = -1;
        if (idx < 387) {
            const int p = idx / 129, i = idx % 129;
            const int dil = (p == 0) ? 1 : (p == 1 ? 4 : 16);
            const int kpos = t - i * dil;
            if (kpos >= 0) {
                const float* kr = z + (rowb + kpos) * INW + 2048 + h * 64;
                float d = 0.f;
                for (int dd = 0; dd < 64; ++dd) d += qp[dd] * kr[dd];
                sc[j] = d * 0.125f; kp[j] = kpos;
            }
        }
        mx = fmaxf(mx, sc[j]);
    }
    mx = wave_max(mx);
    float l = 0.f;
#pragma unroll
    for (int j = 0; j < 7; ++j) {
        const int idx = lane + 64 * j;
        const float e = (kp[j] >= 0) ? expf(sc[j] - mx) : 0.f;
        l += e;
        if (idx < 392) { esh[wv][idx] = e; ksh[wv][idx] = kp[j]; }
    }
    l = wave_sum(l);
    __syncthreads();
    float acc = 0.f;
    for (int idx = 0; idx < 387; ++idx) {
        const int kpos = ksh[wv][idx];
        if (kpos >= 0) acc += esh[wv][idx] * z[(rowb + kpos) * INW + 2304 + h * 64 + lane];
    }
    ycat[(rowb + t) * ND + 768 + h * 64 + lane] = acc / l;
}

__global__ void __launch_bounds__(256) k_router(const float* __restrict__ x, const float* __restrict__ g, const float* __restrict__ modl,
                                                 const float* __restrict__ w_rg, const float* __restrict__ b_rg, const float* __restrict__ w_re, const float* __restrict__ b_re,
                                                 float* __restrict__ h, int* __restrict__ sel_e, float* __restrict__ sel_w) {
    const int row = blockIdx.x * 4 + (threadIdx.x >> 6), lane = threadIdx.x & 63;
    const int b = row / NS;
    const float* xr = x + (size_t)row * ND;
    float v[16]; float ss = 0.f;
#pragma unroll
    for (int j = 0; j < 16; ++j) { v[j] = xr[lane + 64 * j]; ss += v[j] * v[j]; }
    ss = wave_sum(ss);
    const float rstd = 1.0f / sqrtf(ss * (1.f / ND) + EPS);
    const float* mb = modl + (size_t)b * NMOD;
#pragma unroll
    for (int j = 0; j < 16; ++j) {
        const int d = lane + 64 * j;
        v[j] = v[j] * rstd * g[d] * (1.f + mb[4096 + d]) + mb[3072 + d];
        h[(size_t)row * ND + d] = v[j];
    }
    float gl[4];
#pragma unroll
    for (int gi = 0; gi < 4; ++gi) {
        float a = 0.f;
#pragma unroll
        for (int j = 0; j < 16; ++j) a += v[j] * w_rg[(lane + 64 * j) * 4 + gi];
        gl[gi] = wave_sum(a) + b_rg[gi];
    }
    int gidx = 0; float gm = gl[0];
#pragma unroll
    for (int gi = 1; gi < 4; ++gi) if (gl[gi] > gm) { gm = gl[gi]; gidx = gi; }
    float gs = 0.f;
#pragma unroll
    for (int gi = 0; gi < 4; ++gi) gs += expf(gl[gi] - gm);
    const float g_w = 1.0f / gs;
    float el[8];
    const float* wre = w_re + (size_t)gidx * ND * 8;
#pragma unroll
    for (int e = 0; e < 8; ++e) {
        float a = 0.f;
#pragma unroll
        for (int j = 0; j < 16; ++j) a += v[j] * wre[(lane + 64 * j) * 8 + e];
        el[e] = wave_sum(a) + b_re[gidx * 8 + e];
    }
    int i0 = 0; float v0 = el[0];
#pragma unroll
    for (int e = 1; e < 8; ++e) if (el[e] > v0) { v0 = el[e]; i0 = e; }
    int i1 = -1; float v1 = -INFINITY;
#pragma unroll
    for (int e = 0; e < 8; ++e) if (e != i0 && el[e] > v1) { v1 = el[e]; i1 = e; }
    const float e1 = expf(v1 - v0);
    const float w0 = 1.0f / (1.0f + e1), w1 = e1 / (1.0f + e1);
    if (lane == 0) {
        sel_e[row * 2] = gidx * 8 + i0; sel_e[row * 2 + 1] = gidx * 8 + i1;
        sel_w[row * 2] = w0 * g_w; sel_w[row * 2 + 1] = w1 * g_w;
    }
}

__global__ void __launch_bounds__(256) k_moe(const float* __restrict__ h, const int* __restrict__ sel_e, const float* __restrict__ sel_w,
                                              const float* __restrict__ w1, const float* __restrict__ w3, const float* __restrict__ w2,
                                              const float* __restrict__ xin, const float* __restrict__ modl, float* __restrict__ xout) {
    __shared__ float hs[ND];
    __shared__ float hid[256];
    const int tid = threadIdx.x, row = blockIdx.x, b = row / NS;
    for (int i = tid; i < ND; i += 256) hs[i] = h[(size_t)row * ND + i];
    float y[4] = {0.f, 0.f, 0.f, 0.f};
    for (int s = 0; s < 2; ++s) {
        const int e = sel_e[row * 2 + s]; const float cw = sel_w[row * 2 + s];
        __syncthreads();
        const float* p1 = w1 + (size_t)e * ND * 256 + tid;
        const float* p3 = w3 + (size_t)e * ND * 256 + tid;
        float a = 0.f, c = 0.f;
        for (int d = 0; d < ND; ++d) { a += hs[d] * p1[(size_t)d * 256]; c += hs[d] * p3[(size_t)d * 256]; }
        hid[tid] = (a / (1.f + expf(-a))) * c * cw;
        __syncthreads();
        const float* p2 = w2 + (size_t)e * 256 * ND;
        for (int f = 0; f < 256; ++f) {
            const float hv = hid[f];
#pragma unroll
            for (int j = 0; j < 4; ++j) y[j] += hv * p2[(size_t)f * ND + tid + 256 * j];
        }
    }
    const float* mb = modl + (size_t)b * NMOD + 5120;
#pragma unroll
    for (int j = 0; j < 4; ++j) { const int n = tid + 256 * j; xout[(size_t)row * ND + n] = xin[(size_t)row * ND + n] + mb[n] * y[j]; }
}

extern "C" void kernel_launch(void* const* d_in, const int* in_sizes, int n_in, void* d_out, int out_size, void* d_ws, size_t ws_size, hipStream_t stream) {
    const float* x = (const float*)d_in[0];
    const float* c = (const float*)d_in[1];
    const float* w_mod = (const float*)d_in[2];
    const float* b_mod = (const float*)d_in[3];
    const float* g_norm1 = (const float*)d_in[4];
    const float* w_in = (const float*)d_in[5];
    const float* gq_a = (const float*)d_in[6];
    const float* gk_a = (const float*)d_in[7];
    const float* lam_a = (const float*)d_in[8];
    const float* g_sub_a = (const float*)d_in[9];
    const float* w_pool = (const float*)d_in[10];
    const float* b_pool = (const float*)d_in[11];
    const float* pool_scale = (const float*)d_in[12];
    const float* gq_c = (const float*)d_in[13];
    const float* gk_c = (const float*)d_in[14];
    const float* w_out = (const float*)d_in[15];
    const float* g_norm2 = (const float*)d_in[16];
    const float* w_rg = (const float*)d_in[17];
    const float* b_rg = (const float*)d_in[18];
    const float* w_re = (const float*)d_in[19];
    const float* b_re = (const float*)d_in[20];
    const float* w1 = (const float*)d_in[21];
    const float* w3 = (const float*)d_in[22];
    const float* w2 = (const float*)d_in[23];
    float* out = (float*)d_out;
    float* ws = (float*)d_ws;
    const size_t MiBf = (1u << 20) / 4;
    float* mod = ws;
    float* cosT = ws + 131072;
    float* sinT = ws + 196608;
    float* lamv = ws + 262144;
    int* sel_e = (int*)(ws + 262144 + 1024);
    float* sel_w = ws + 262144 + 1024 + 32768;
    float* H = ws + 2 * MiBf;
    float* Z = H + 64 * MiBf;
    float* X1 = Z + 160 * MiBf;

    k_mod<<<NL * NMOD / 256, 256, 0, stream>>>(c, w_mod, b_mod, mod);
    k_misc<<<NS * 32 / 256, 256, 0, stream>>>(lam_a, lamv, cosT, sinT);
    const float* xcur = x;
    for (int l = 0; l < NL; ++l) {
        const float* modl = mod + (size_t)l * NB * NMOD;
        k_ln<<<NT / 4, 256, 0, stream>>>(xcur, g_norm1 + l * ND, modl, 0, 1024, H);
        k_gemm<0><<<dim3(INW / 64, NT / 64), 256, 0, stream>>>(H, w_in + (size_t)l * ND * INW, Z, NT, INW, ND, nullptr, nullptr);
        k_qkprep<<<NT * 24 / 4, 256, 0, stream>>>(Z, gq_a + l * 64, gk_a + l * 64, gq_c + l * 64, gk_c + l * 64, cosT, sinT);
        k_diffattn<<<NB * 4 * NS, 256, 0, stream>>>(Z, lamv + 2 * l, g_sub_a + l * 128, H);
        k_pool<<<NT, 256, 0, stream>>>(Z, w_pool + l * 16384, b_pool + l * 256, pool_scale + l * 256, H);
        k_dilated<<<NB * 4 * NS / 4, 256, 0, stream>>>(Z, H);
        k_gemm<1><<<dim3(ND / 64, NT / 64), 256, 0, stream>>>(H, w_out + (size_t)l * ND * ND, X1, NT, ND, ND, xcur, modl + 2048);
        k_router<<<NT / 4, 256, 0, stream>>>(X1, g_norm2 + l * ND, modl, w_rg + l * ND * 4, b_rg + l * 4, w_re + (size_t)l * 4 * ND * 8, b_re + l * 32, H, sel_e, sel_w);
        k_moe<<<NT, 256, 0, stream>>>(H, sel_e, sel_w, w1 + (size_t)l * 32 * ND * 256, w3 + (size_t)l * 32 * ND * 256, w2 + (size_t)l * 32 * 256 * ND, X1, modl, out);
        xcur = out;
    }
}
```

```cpp
#include <hip/hip_runtime.h>
#include <math.h>
#include <stdint.h>

constexpr int NB = 8, NS = 2048, ND = 1024, NT = NB * NS, NL = 2;
constexpr int INW = 2560, NMOD = 6144, NEXP = 32, NF = 256;
constexpr float EPS = 1e-6f;
constexpr float QSCALE = 0.125f * 1.4426950408889634f;

#define LAS __attribute__((address_space(3)))
#define GAS __attribute__((address_space(1)))
typedef unsigned short bf16_t;
typedef short bf16x8 __attribute__((ext_vector_type(8)));
typedef float f32x4 __attribute__((ext_vector_type(4)));
typedef float f32x16 __attribute__((ext_vector_type(16)));
typedef unsigned u32x4 __attribute__((ext_vector_type(4)));
typedef unsigned u32x2 __attribute__((ext_vector_type(2)));

__device__ const double ROPE_REV[32] = {
1.59154943091895345608e-01, 1.19349370211248861917e-01, 8.94994016088910132600e-02, 6.71150830052272551196e-02,
5.03292121044870352509e-02, 3.77415847174197710556e-02, 2.83021958306233986646e-02, 2.12236527647776604399e-02,
1.59154943091895338669e-02, 1.19349370211248861917e-02, 8.94994016088910236684e-03, 6.71150830052272533849e-03,
5.03292121044870369856e-03, 3.77415847174197719230e-03, 2.83021958306233986646e-03, 2.12236527647776621747e-03,
1.59154943091895334333e-03, 1.19349370211248848907e-03, 8.94994016088910128263e-04, 6.71150830052272490481e-04,
5.03292121044870326488e-04, 3.77415847174197686704e-04, 2.83021958306233954120e-04, 2.12236527647776605484e-04,
1.59154943091895323490e-04, 1.19349370211248848907e-04, 8.94994016088910182474e-05, 6.71150830052272544691e-05,
5.03292121044870353593e-05, 3.77415847174197700256e-05, 2.83021958306233960897e-05, 2.12236527647776591931e-05};

__device__ __forceinline__ float bf2f(bf16_t v) { return __uint_as_float(((unsigned)v) << 16); }
__device__ __forceinline__ unsigned f2bf_u(float f) { unsigned u = __float_as_uint(f); return (u + 0x7fffu + ((u >> 16) & 1u)) >> 16; }
__device__ __forceinline__ bf16_t f2bf(float f) { return (bf16_t)f2bf_u(f); }
__device__ __forceinline__ unsigned pk2(float lo, float hi) { return f2bf_u(lo) | (f2bf_u(hi) << 16); }
template <int CTRL> __device__ __forceinline__ float dpp_f(float v) { return __int_as_float(__builtin_amdgcn_update_dpp(0, __float_as_int(v), CTRL, 0xf, 0xf, true)); }
__device__ __forceinline__ float xor16_f(float v) { return __int_as_float(__builtin_amdgcn_ds_swizzle(__float_as_int(v), 0x401F)); }
__device__ __forceinline__ float xor32_sum(float v) { auto r = __builtin_amdgcn_permlane32_swap(__float_as_uint(v), __float_as_uint(v), false, false); return __uint_as_float(r[0]) + __uint_as_float(r[1]); }
__device__ __forceinline__ float sum_fq(float v) { v += xor16_f(v); return xor32_sum(v); }
__device__ __forceinline__ float wave_sum(float v) {
    v += dpp_f<0xB1>(v); v += dpp_f<0x4E>(v); v += dpp_f<0x141>(v); v += dpp_f<0x140>(v); v += xor16_f(v);
    return xor32_sum(v);
}
__device__ __forceinline__ float wave_max(float v) {
    v = fmaxf(v, dpp_f<0xB1>(v)); v = fmaxf(v, dpp_f<0x4E>(v)); v = fmaxf(v, dpp_f<0x141>(v)); v = fmaxf(v, dpp_f<0x140>(v)); v = fmaxf(v, xor16_f(v));
    auto r = __builtin_amdgcn_permlane32_swap(__float_as_uint(v), __float_as_uint(v), false, false); return fmaxf(__uint_as_float(r[0]), __uint_as_float(r[1]));
}

constexpr size_t MiB = 1u << 20;
constexpr size_t WS_CTL = 0, CTL_ZERO_BYTES = 1 * MiB;
constexpr size_t WS_MOD = 1 * MiB;
constexpr size_t WS_COS = 1 * MiB + 512 * 1024, WS_SIN = 1 * MiB + 768 * 1024;
constexpr size_t WS_LAM = 2 * MiB;
constexpr size_t WS_GAINS = 2 * MiB + 4096;
constexpr size_t WS_SELW = 2 * MiB + 64 * 1024;
constexpr size_t WS_PERM = 3 * MiB;
constexpr size_t WS_WIN = 6 * MiB;
constexpr size_t WS_WOUT = 16 * MiB;
constexpr size_t WS_WUP = 20 * MiB;
constexpr size_t WS_WDN = 84 * MiB;
constexpr size_t WS_HB = 116 * MiB;
constexpr size_t WS_ZB = 148 * MiB;
constexpr size_t WS_HID = 228 * MiB;
constexpr size_t WS_END = 248 * MiB;
constexpr int CW_BAR = 4096;
constexpr int CW_CNT = 8192;

namespace pg8 {
constexpr int BM = 256, BK = 64, HALF = 128, HTB = HALF * BK * 2  , STAGE_BYTES = 8 * HTB, NXCD = 8, WGM = 8;

__host__ __device__ __forceinline__ int lds_byte(int r, int c) { const int st = (r >> 4) * 2 + (c >> 5), rr = r & 15, cc = c & 31, ob = rr * 64 + cc * 2; return st * 1024 + (ob ^ (((ob >> 9) & 1) << 5)); }
__host__ __device__ __forceinline__ void stage_rc(int b, int& R, int& C) { const int st = b / 1024, sb = b % 1024, swz = sb ^ (((sb >> 9) & 1) << 5); R = (st >> 1) * 16 + swz / 64; C = (st & 1) * 32 + (swz % 64) / 2; }
__host__ __device__ __forceinline__ int perm32(int rho) { const int n = rho >> 4, i = rho & 15; return 8 * (i >> 2) + 4 * n + (i & 3); }

struct Unit { int pm, pn, aux; };
struct Gemm { const bf16_t* A; const bf16_t* Bt; int K; };

struct StaticOrder {
    int nM, nN, nwg, G, c;
    __device__ void init(int M, int N, int G_, int c_) { nM = M / BM; nN = N / BM; nwg = nM * nN; G = G_; c = c_; }
    __device__ bool next(int i, Unit& u) const {
        const long L = (long)i * G + c; if (L >= nwg) return false;
        int wgid = (int)L; { const int q = nwg / NXCD, r = nwg % NXCD, xcd = wgid % NXCD, off = wgid / NXCD; wgid = (xcd < r ? xcd * (q + 1) : r * (q + 1) + (xcd - r) * q) + off; }
        const int nig = WGM * nN, gid = wgid / nig, fm = gid * WGM, gsz = (nM - fm) < WGM ? (nM - fm) : WGM;
        u.pm = fm + ((wgid % nig) % gsz); u.pn = (wgid % nig) / gsz; u.aux = 0; return true;
    }
    __device__ __forceinline__ unsigned a_off(int, int) const { return 0u; }
};
struct GroupedOrder {
    const LAS int* tab;
    const LAS unsigned* rowoff;
    int n_local;
    __device__ __forceinline__ bool next(int i, Unit& u) const { if (i >= n_local) return false; u.pm = tab[i * 4]; u.pn = tab[i * 4 + 1]; u.aux = i; return true; }
    __device__ __forceinline__ unsigned a_off(int i, int rr) const { return rowoff[i * 256 + rr]; }
};

template <class Epi, class Sched, bool ALIGN_EPI, bool GATHER>
__device__ __forceinline__ void gemm_phase(LAS unsigned char* lds, const int tid, const Gemm g, const Sched& S, const Epi& E) {
    const int wid = __builtin_amdgcn_readfirstlane(tid >> 6), lane = tid & 63, wr = wid >> 2, wc = wid & 3, fr = lane & 15, fq = lane >> 4;
    const int K = g.K, nt = K / BK;
    unsigned voffA[2], voffB[2]; int Rrow[2];
#pragma unroll
    for (int i = 0; i < 2; ++i) { int R, C; stage_rc(tid * 16 + i * 8192, R, C); const int Rb = Epi::PERM ? ((R & ~31) + perm32(R & 31)) : R;
        voffA[i] = GATHER ? (unsigned)(C * 2) : (unsigned)(R * K + C) * 2u; voffB[i] = (unsigned)(Rb * K + C) * 2u; Rrow[i] = R; }
    const size_t kstep = (size_t)(BK * 2);
    const size_t hstep = (size_t)HALF * K * 2;
    const size_t hstepA = GATHER ? 0 : hstep;
    const size_t tstep = 2 * hstep;
    const unsigned ldsw = (unsigned)wid * 1024u;
    const int aoff = lds_byte(wr * 64 + fr, fq * 8), boff = lds_byte(wc * 32 + fr, fq * 8);
#define PG8_SA(b, h) (((b) * 2 + (h)) * HTB)
#define PG8_SB(b, h) ((4 + (b) * 2 + (h)) * HTB)
#define PG8_STAGE(bufoff, gbase, voff) do { _Pragma("unroll") for (int _i = 0; _i < 2; ++_i) \
        __builtin_amdgcn_global_load_lds((const unsigned*)((const char*)(gbase) + (voff)[_i]), (LAS unsigned*)(lds + (bufoff) + ldsw + _i * 8192), 16, 0, 0); } while (0)
#define PG8_LDA(dst, b, h) do { _Pragma("unroll") for (int m = 0; m < 4; ++m) _Pragma("unroll") for (int k = 0; k < 2; ++k) dst[m][k] = *(const LAS bf16x8*)(lds + PG8_SA(b, h) + aoff + m * 2048 + k * 1024); } while (0)
#define PG8_LDB(dst, b, h) do { _Pragma("unroll") for (int n = 0; n < 2; ++n) _Pragma("unroll") for (int k = 0; k < 2; ++k) dst[n][k] = *(const LAS bf16x8*)(lds + PG8_SB(b, h) + boff + n * 2048 + k * 1024); } while (0)
#define PG8_MMA(ai, bj, At, Bt) do { __builtin_amdgcn_s_setprio(1); _Pragma("unroll") for (int m = 0; m < 4; ++m) _Pragma("unroll") for (int n = 0; n < 2; ++n) _Pragma("unroll") for (int k = 0; k < 2; ++k) \
        acc[ai][bj][m][n] = __builtin_amdgcn_mfma_f32_16x16x32_bf16(Bt[n][k], At[m][k], acc[ai][bj][m][n], 0, 0, 0); __builtin_amdgcn_s_setprio(0); } while (0)
#define PG8_WAIT_V(n) asm volatile("s_waitcnt vmcnt(" #n ")" ::: "memory")
#define PG8_WAIT_L(n) asm volatile("s_waitcnt lgkmcnt(" #n ")" ::: "memory")
#define PG8_BAR __builtin_amdgcn_s_barrier()
#define PG8_SCHED __builtin_amdgcn_sched_barrier(0)
    Unit cur, nxt; int ui = 0;
    if (!S.next(0, cur)) return;
    f32x4 acc[2][2][4][2];
#pragma unroll
    for (int a = 0; a < 2; ++a)
#pragma unroll
        for (int b = 0; b < 2; ++b)
#pragma unroll
            for (int m = 0; m < 4; ++m)
#pragma unroll
                for (int n = 0; n < 2; ++n) acc[a][b][m][n] = (f32x4){0.f, 0.f, 0.f, 0.f};
    bf16x8 At[4][2], B0[2][2], B1[2][2];
    unsigned vAc0[2], vAc1[2], vAn0[2], vAn1[2];
#pragma unroll
    for (int i = 0; i < 2; ++i) {
        if (GATHER) { vAc0[i] = S.a_off(cur.aux, Rrow[i]) + voffA[i]; vAc1[i] = S.a_off(cur.aux, HALF + Rrow[i]) + voffA[i]; }
        else { vAc0[i] = voffA[i]; vAc1[i] = voffA[i]; }
        vAn0[i] = vAc0[i]; vAn1[i] = vAc1[i];
    }
    const char* cA = (const char*)g.A + (GATHER ? (size_t)0 : (size_t)cur.pm * tstep); const char* cB = (const char*)g.Bt + (size_t)cur.pn * tstep;
    PG8_STAGE(PG8_SB(0, 0), cB, voffB); PG8_STAGE(PG8_SB(0, 1), cB + hstep, voffB); PG8_STAGE(PG8_SA(0, 0), cA, vAc0); PG8_STAGE(PG8_SA(0, 1), cA + hstepA, vAc1);
    if (wr == 1) PG8_BAR;
    PG8_WAIT_V(2); PG8_BAR;
    PG8_STAGE(PG8_SB(1, 0), cB + kstep, voffB); PG8_STAGE(PG8_SA(1, 0), cA + kstep, vAc0); PG8_STAGE(PG8_SB(1, 1), cB + hstep + kstep, voffB);
    PG8_WAIT_V(6); PG8_BAR;
    for (;;) {
        const bool has_next = S.next(ui + 1, nxt);
        const char* nA = has_next ? (const char*)g.A + (GATHER ? (size_t)0 : (size_t)nxt.pm * tstep) : cA; const char* nB = has_next ? (const char*)g.Bt + (size_t)nxt.pn * tstep : cB;
        if (GATHER) {
#pragma unroll
            for (int i = 0; i < 2; ++i) {
                if (has_next) { vAn0[i] = S.a_off(nxt.aux, Rrow[i]) + voffA[i]; vAn1[i] = S.a_off(nxt.aux, HALF + Rrow[i]) + voffA[i]; }
                else { vAn0[i] = vAc0[i]; vAn1[i] = vAc1[i]; }
            }
        }
#pragma unroll 1
        for (int t = 0; t < nt; t += 2) {
            const bool last = (t == nt - 2);
            const char* a1 = cA + (size_t)(t + 1) * kstep;
            const char* a2 = last ? nA : cA + (size_t)(t + 2) * kstep; const char* b2 = last ? nB : cB + (size_t)(t + 2) * kstep;
            const char* a3 = a2 + kstep; const char* b3 = b2 + kstep;
            unsigned vs0[2], vs1[2];
#pragma unroll
            for (int i = 0; i < 2; ++i) { vs0[i] = (GATHER && last) ? vAn0[i] : vAc0[i]; vs1[i] = (GATHER && last) ? vAn1[i] : vAc1[i]; }
            PG8_LDB(B0, 0, 0); PG8_LDB(B1, 0, 1); PG8_SCHED; PG8_LDA(At, 0, 0); PG8_STAGE(PG8_SA(1, 1), a1 + hstepA, vAc1);
            PG8_WAIT_V(8); PG8_WAIT_L(0); PG8_BAR; PG8_MMA(0, 0, At, B0); PG8_MMA(0, 1, At, B1); PG8_BAR; PG8_SCHED;
            PG8_LDA(At, 0, 1); PG8_STAGE(PG8_SB(0, 0), b2, voffB); PG8_STAGE(PG8_SB(0, 1), b2 + hstep, voffB); PG8_STAGE(PG8_SA(0, 0), a2, vs0);
            PG8_WAIT_V(8); PG8_WAIT_L(0); PG8_BAR; PG8_MMA(1, 0, At, B0); PG8_MMA(1, 1, At, B1); PG8_BAR; PG8_SCHED;
            PG8_LDB(B0, 1, 0); PG8_LDB(B1, 1, 1); PG8_SCHED; PG8_LDA(At, 1, 0); PG8_STAGE(PG8_SA(0, 1), a2 + hstepA, vs1);
            PG8_WAIT_V(8); PG8_WAIT_L(0); PG8_BAR; PG8_MMA(0, 0, At, B0); PG8_MMA(0, 1, At, B1); PG8_BAR; PG8_SCHED;
            PG8_LDA(At, 1, 1); PG8_STAGE(PG8_SB(1, 0), b3, voffB); PG8_STAGE(PG8_SB(1, 1), b3 + hstep, voffB); PG8_STAGE(PG8_SA(1, 0), a3, vs0);
            PG8_WAIT_V(8); PG8_WAIT_L(0); PG8_BAR; PG8_MMA(1, 0, At, B0); PG8_MMA(1, 1, At, B1); PG8_BAR; PG8_SCHED;
        }
        if constexpr (ALIGN_EPI) { if (wr == 0) PG8_BAR; }
        E(acc, cur, wr, wc, fr, fq);
        if (!has_next) break;
#pragma unroll
        for (int a = 0; a < 2; ++a)
#pragma unroll
            for (int b = 0; b < 2; ++b)
#pragma unroll
                for (int m = 0; m < 4; ++m)
#pragma unroll
                    for (int n = 0; n < 2; ++n) acc[a][b][m][n] = (f32x4){0.f, 0.f, 0.f, 0.f};
        cur = nxt; cA = nA; cB = nB; ++ui;
#pragma unroll
        for (int i = 0; i < 2; ++i) { vAc0[i] = vAn0[i]; vAc1[i] = vAn1[i]; }
        if constexpr (ALIGN_EPI) { if (wr == 1) PG8_BAR; }
    }
    PG8_WAIT_V(0);
    if constexpr (!ALIGN_EPI) { if (wr == 0) PG8_BAR; }
    PG8_BAR;
#undef PG8_SA
#undef PG8_SB
#undef PG8_STAGE
#undef PG8_LDA
#undef PG8_LDB
#undef PG8_MMA
#undef PG8_WAIT_V
#undef PG8_WAIT_L
#undef PG8_BAR
#undef PG8_SCHED
}

__device__ __forceinline__ unsigned cvt_pk_bf16(float lo, float hi) { unsigned r; asm volatile("v_cvt_pk_bf16_f32 %0, %1, %2" : "=v"(r) : "v"(lo), "v"(hi)); return r; }

struct EpiInProj {
    static constexpr bool PERM = true;
    bf16_t* Z; const float *gains  , *cosT, *sinT;
    __device__ __forceinline__ void operator()(const f32x4 (&acc)[2][2][4][2], const Unit& u, int wr, int wc, int fr, int fq) const {
        const int pn = u.pn;
        const int row0 = u.pm * BM + wr * 64 + fr;
        const int colbase = pn * 256 + wc * 64 + 8 * fq;
        const bool normed = (pn < 4) || (pn == 7) || (pn == 8);
        if (normed) {
            const int gi = (pn < 2) ? 0 : (pn < 4) ? 1 : (pn == 7) ? 2 : 3;
            const float* gain = gains + gi * 64;
            const float qs = (pn < 2 || pn == 7) ? QSCALE : 1.0f;
            f32x4 g[2][2];
#pragma unroll
            for (int bj = 0; bj < 2; ++bj)
#pragma unroll
                for (int n = 0; n < 2; ++n) g[bj][n] = *(const f32x4*)(gain + 32 * bj + 8 * fq + 4 * n) * qs;
#pragma unroll
            for (int ai = 0; ai < 2; ++ai)
#pragma unroll
                for (int m = 0; m < 4; ++m) {
                    const int row = row0 + ai * HALF + m * 16, pos = row & (NS - 1);
                    float ss = 0.f;
#pragma unroll
                    for (int bj = 0; bj < 2; ++bj)
#pragma unroll
                        for (int n = 0; n < 2; ++n) { const f32x4 v = acc[ai][bj][m][n]; ss += (v[0] * v[0] + v[1] * v[1]) + (v[2] * v[2] + v[3] * v[3]); }
                    ss = sum_fq(ss);
                    const float rstd = 1.0f / sqrtf(ss * (1.f / 64.f) + EPS);
                    u32x4 wlo, whi;
#pragma unroll
                    for (int n = 0; n < 2; ++n) {
                        const f32x4 c = *(const f32x4*)(cosT + pos * 32 + 8 * fq + 4 * n), s = *(const f32x4*)(sinT + pos * 32 + 8 * fq + 4 * n);
                        const f32x4 lo = acc[ai][0][m][n] * rstd * g[0][n], hi = acc[ai][1][m][n] * rstd * g[1][n];
                        const f32x4 olo = lo * c - hi * s, ohi = hi * c + lo * s;
                        wlo[2 * n] = cvt_pk_bf16(olo[0], olo[1]); wlo[2 * n + 1] = cvt_pk_bf16(olo[2], olo[3]);
                        whi[2 * n] = cvt_pk_bf16(ohi[0], ohi[1]); whi[2 * n + 1] = cvt_pk_bf16(ohi[2], ohi[3]);
                    }
                    bf16_t* rowp = Z + (size_t)row * INW + colbase;
                    *(u32x4*)(rowp) = wlo; *(u32x4*)(rowp + 32) = whi;
                    asm volatile("" ::: "memory");
                }
        } else {
#pragma unroll
            for (int ai = 0; ai < 2; ++ai)
#pragma unroll
                for (int m = 0; m < 4; ++m) {
                    bf16_t* rowp = Z + (size_t)(row0 + ai * HALF + m * 16) * INW + colbase;
#pragma unroll
                    for (int bj = 0; bj < 2; ++bj) { const f32x4 v0 = acc[ai][bj][m][0], v1 = acc[ai][bj][m][1];
                        u32x4 w; w.x = cvt_pk_bf16(v0[0], v0[1]); w.y = cvt_pk_bf16(v0[2], v0[3]); w.z = cvt_pk_bf16(v1[0], v1[1]); w.w = cvt_pk_bf16(v1[2], v1[3]);
                        *(u32x4*)(rowp + 32 * bj) = w; }
                }
        }
    }
};
struct EpiResid {
    static constexpr bool PERM = false;
    const float* resid; float* out; const float* ga;
    __device__ __forceinline__ void operator()(const f32x4 (&acc)[2][2][4][2], const Unit& u, int wr, int wc, int fr, int fq) const {
        const int row0 = u.pm * BM + wr * 64 + fr, col0 = u.pn * BM + wc * 32 + 4 * fq;
        const int b = (u.pm * BM) / NS;
        f32x4 gv[2][2];
#pragma unroll
        for (int bj = 0; bj < 2; ++bj)
#pragma unroll
            for (int n = 0; n < 2; ++n) gv[bj][n] = *(const f32x4*)(ga + (size_t)b * NMOD + col0 + bj * HALF + n * 16);
#pragma unroll
        for (int ai = 0; ai < 2; ++ai)
#pragma unroll
            for (int m = 0; m < 4; ++m) { const size_t off = (size_t)(row0 + ai * HALF + m * 16) * ND + col0;
#pragma unroll
                for (int bj = 0; bj < 2; ++bj)
#pragma unroll
                    for (int n = 0; n < 2; ++n) { const f32x4 r = *(const f32x4*)(resid + off + bj * HALF + n * 16); *(f32x4*)(out + off + bj * HALF + n * 16) = r + gv[bj][n] * acc[ai][bj][m][n]; } }
    }
};
struct EpiSwiGLU {
    static constexpr bool PERM = true;
    bf16_t* hid;
    __device__ __forceinline__ void operator()(const f32x4 (&acc)[2][2][4][2], const Unit& u, int wr, int wc, int fr, int fq) const {
        const int row0 = u.pm * BM + wr * 64 + fr, f0 = (u.pn & 1) * 128 + wc * 16 + 4 * fq;
#pragma unroll
        for (int ai = 0; ai < 2; ++ai)
#pragma unroll
            for (int m = 0; m < 4; ++m) { bf16_t* rowp = hid + (size_t)(row0 + ai * HALF + m * 16) * NF + f0;
#pragma unroll
                for (int bj = 0; bj < 2; ++bj) { const f32x4 a = acc[ai][bj][m][0], c = acc[ai][bj][m][1]; f32x4 h;
#pragma unroll
                    for (int j = 0; j < 4; ++j) h[j] = a[j] * __builtin_amdgcn_rcpf(1.0f + __expf(-a[j])) * c[j];
                    u32x2 w; w.x = cvt_pk_bf16(h[0], h[1]); w.y = cvt_pk_bf16(h[2], h[3]);
                    *(u32x2*)(rowp + 64 * bj) = w; }
            }
    }
};
struct EpiScatter {
    static constexpr bool PERM = true;
    bf16_t* ym;
    const LAS int* rdest; const LAS float* rcw;
    __device__ __forceinline__ void operator()(const f32x4 (&acc)[2][2][4][2], const Unit& u, int wr, int wc, int fr, int fq) const {
        const int col0 = (u.pn & 3) * 256 + wc * 32 + 8 * fq;
#pragma unroll
        for (int ai = 0; ai < 2; ++ai)
#pragma unroll
            for (int m = 0; m < 4; ++m) {
                const int r = ai * HALF + wr * 64 + m * 16 + fr;
                const int dest = rdest[u.aux * 256 + r]; const float cw = rcw[u.aux * 256 + r];
                if (dest >= 0) {
                    bf16_t* rowp = ym + (size_t)dest * ND + col0;
#pragma unroll
                    for (int bj = 0; bj < 2; ++bj) {
                        const f32x4 v0 = acc[ai][bj][m][0] * cw, v1 = acc[ai][bj][m][1] * cw;
                        u32x4 w; w.x = cvt_pk_bf16(v0[0], v0[1]); w.y = cvt_pk_bf16(v0[2], v0[3]); w.z = cvt_pk_bf16(v1[0], v1[1]); w.w = cvt_pk_bf16(v1[2], v1[3]);
                        *(u32x4*)(rowp + bj * HALF) = w; }
                }
                asm volatile("" ::: "memory");
            }
    }
};
}

constexpr int NWAVES = 8;
constexpr int RING_BYTES = 131072;
constexpr int TAB_OFF = RING_BYTES;
constexpr int TAB_BYTES = 14336;
constexpr int MISC_OFF = TAB_OFF + TAB_BYTES;
constexpr int LDS_BYTES = 147456;
static_assert(MISC_OFF + 256 <= LDS_BYTES, "LDS map");

typedef GAS unsigned gu32;
#define RLX_AGENT __ATOMIC_RELAXED, __HIP_MEMORY_SCOPE_AGENT
#define LDS_WAIT() asm volatile("s_waitcnt lgkmcnt(0)" ::: "memory")
#define VM_WAIT() asm volatile("s_waitcnt vmcnt(0)" ::: "memory")

#define XB_TMO      128
#define XB_XCNT(j)  (256  + 64 * (j))
#define XB_XSUB(j)  (1280 + 64 * (j))
#define XB_XGEN(j)  (2304 + 64 * (j))
#define XB_TOP      3328
#define XB_TOPGEN   3392
#define XCD_BAR_WORDS 3456
#define XB_SPIN_CAP (1u << 18)
__device__ __forceinline__ unsigned xb_ld(unsigned* p)              { return __hip_atomic_load(p, __ATOMIC_RELAXED, __HIP_MEMORY_SCOPE_AGENT); }
__device__ __forceinline__ unsigned xb_add(unsigned* p, unsigned v) { return __hip_atomic_fetch_add(p, v, __ATOMIC_RELAXED, __HIP_MEMORY_SCOPE_AGENT); }
__device__ __forceinline__ unsigned xb_xcc_id() { return (unsigned)__builtin_amdgcn_s_getreg((3 << 11) | 20) & 0xFu; }
#define XB_SPIN(cond, bar) do { unsigned _sp = 0; while (cond) { __builtin_amdgcn_s_sleep(1); \
    if ((++_sp & 255u) == 0u) { if (xb_ld(&(bar)[XB_TMO])) break; if (_sp > XB_SPIN_CAP) { atomicAdd(&(bar)[XB_TMO], 1u); break; } } } } while (0)
struct XcdBarrier { unsigned* bar; unsigned x; volatile LAS unsigned* st; };
__device__ __forceinline__ XcdBarrier xcd_barrier_post(unsigned* bar, volatile LAS unsigned* st) {
    XcdBarrier b; b.bar = bar; b.x = xb_xcc_id(); b.st = st;
    if (threadIdx.x == 0) (void)xb_add(&bar[XB_XCNT(b.x)], 1u);
    return b;
}
__device__ __forceinline__ void xcd_barrier_complete(unsigned* bar, unsigned x, unsigned& nloc, unsigned& nx) {
    const unsigned G = gridDim.x * gridDim.y * gridDim.z;
    unsigned sum, cnt, mine, sp = 0u;
    for (;;) {
        sum = 0u; cnt = 0u; mine = 0u;
#pragma unroll
        for (unsigned j = 0; j < 16; ++j) { const unsigned c = xb_ld(&bar[XB_XCNT(j)]); sum += c; cnt += (c > 0u) ? 1u : 0u; mine = (j == x) ? c : mine; }
        if (sum == G) break;
        __builtin_amdgcn_s_sleep(1);
        if ((++sp & 255u) == 0u) { if (xb_ld(&bar[XB_TMO])) break; if (sp > XB_SPIN_CAP) { atomicAdd(&bar[XB_TMO], 1u); break; } }
    }
    nloc = mine > 0u ? mine : 1u; nx = cnt > 0u ? cnt : 1u;
}
__device__ __forceinline__ void xcd_barrier(const XcdBarrier& b) {
    asm volatile("s_waitcnt vmcnt(0)" ::: "memory");
    __syncthreads();
    if (threadIdx.x == 0) {
        unsigned* bar = b.bar;
        __builtin_amdgcn_s_waitcnt(0);
        unsigned nloc = b.st[0], nx = b.st[1];
        if (nloc == 0u) { xcd_barrier_complete(bar, b.x, nloc, nx); b.st[0] = nloc; b.st[1] = nx; }
        const unsigned old = xb_add(&bar[XB_XSUB(b.x)], 1u);
        const unsigned gen = old / nloc;
        if (old + 1u == (gen + 1u) * nloc) {
            __builtin_amdgcn_fence(__ATOMIC_RELEASE, "agent");
            asm volatile("s_waitcnt vmcnt(0)" ::: "memory");
            const unsigned og = xb_add(&bar[XB_TOP], 1u);
            const unsigned tg = og / nx;
            if (og + 1u == (tg + 1u) * nx) xb_add(&bar[XB_TOPGEN], 1u);
            else XB_SPIN(xb_ld(&bar[XB_TOPGEN]) == tg, bar);
            __builtin_amdgcn_fence(__ATOMIC_ACQUIRE, "agent");
            xb_add(&bar[XB_XGEN(b.x)], 1u);
            asm volatile("s_waitcnt vmcnt(0)" ::: "memory");
        } else {
            XB_SPIN(xb_ld(&bar[XB_XGEN(b.x)]) == gen, bar);
            __builtin_amdgcn_fence(__ATOMIC_ACQUIRE, "agent");
            asm volatile("s_waitcnt vmcnt(0)" ::: "memory");
        }
    }
    __syncthreads();
}

struct Params { const float* in[24]; float* out; unsigned char* ws; int ph_lo, ph_hi; };
enum { I_X = 0, I_C, I_WMOD, I_BMOD, I_GN1, I_WIN, I_GQA, I_GKA, I_LAMA, I_GSUBA, I_WPOOL, I_BPOOL, I_PSCALE, I_GQC, I_GKC, I_WOUT, I_GN2, I_WRG, I_BRG, I_WRE, I_BRE, I_W1, I_W3, I_W2 };

struct Frame {
    LAS unsigned char* lds;
    int tid, lane, wave, vcu, G;
    const float* const* in; float* out; unsigned char* ws;
};

template <class RowMap>
__device__ __forceinline__ void p0_transpose_item(const float* W, int ldw, int K, bf16_t* WT, LAS float* scr, int k0, int n0, int lane, const RowMap& rm) {
#pragma unroll 8
    for (int i = 0; i < 32; ++i) { const int kk = 2 * i + (lane >> 5); scr[kk * 33 + (lane & 31)] = W[(size_t)(k0 + kk) * ldw + n0 + (lane & 31)]; }
    LDS_WAIT(); asm volatile("" ::: "memory");
    const int c = lane & 7;
#pragma unroll
    for (int j = 0; j < 4; ++j) { const int n = (lane >> 3) + 8 * j; const LAS float* s = scr + (8 * c) * 33 + n;
        u32x4 o; o.x = pk2(s[0 * 33], s[1 * 33]); o.y = pk2(s[2 * 33], s[3 * 33]); o.z = pk2(s[4 * 33], s[5 * 33]); o.w = pk2(s[6 * 33], s[7 * 33]);
        *(GAS u32x4*)(WT + (size_t)rm(n0 + n) * K + k0 + 8 * c) = o; }
    LDS_WAIT(); asm volatile("" ::: "memory");
}
struct MapIn  { __device__ __forceinline__ int operator()(int n) const { return (n & ~255) + ((n >> 5) & 1) * 128 + ((n >> 6) & 3) * 32 + (n & 31); } };
struct MapId  { __device__ __forceinline__ int operator()(int n) const { return n; } };
struct MapUp  { int which; __device__ __forceinline__ int operator()(int f) const { return (f >> 7) * 256 + ((f >> 6) & 1) * 128 + ((f >> 4) & 3) * 32 + ((f >> 2) & 3) * 8 + which * 4 + (f & 3); } };

__device__ __forceinline__ void p0_prologue(Frame& F) {
    LAS float* scr = (LAS float*)(F.lds + F.wave * 8704);
    const int gw = F.vcu * NWAVES + F.wave, NGW = F.G * NWAVES;
    {
        LAS float* cond = (LAS float*)(F.lds + 98304);
        for (int i = F.tid; i < NB * ND; i += NWAVES * 64) { const float v = F.in[I_C][i]; cond[i] = v / (1.f + __expf(-v)); }
        __syncthreads();
        const int gwm = F.wave * F.G + F.vcu;
        for (int it = gwm; it < NL * (NMOD / 32); it += NGW) {
            const int l = it / (NMOD / 32), j = (it % (NMOD / 32)) * 32 + (F.lane & 31), kh = F.lane >> 5;
            const float* w = F.in[I_WMOD] + (size_t)l * ND * NMOD + (size_t)kh * 512 * NMOD + j;
            const LAS float* cd = cond + kh * 512;
            float acc[NB];
#pragma unroll
            for (int b = 0; b < NB; ++b) acc[b] = 0.f;
            for (int d0 = 0; d0 < 512; d0 += 32) {
                float wv[32];
#pragma unroll
                for (int q = 0; q < 32; ++q) wv[q] = w[(size_t)(d0 + q) * NMOD];
#pragma unroll
                for (int q = 0; q < 32; ++q)
#pragma unroll
                    for (int b = 0; b < NB; ++b) acc[b] += cd[b * ND + d0 + q] * wv[q];
            }
            float* mod = (float*)(F.ws + WS_MOD);
#pragma unroll
            for (int b = 0; b < NB; ++b) { const float tot = xor32_sum(acc[b]); if (kh == 0) mod[(size_t)(l * NB + b) * NMOD + j] = tot + F.in[I_BMOD][l * NMOD + j]; }
        }
    }
    {
        float* cosT = (float*)(F.ws + WS_COS); float* sinT = (float*)(F.ws + WS_SIN);
        for (int idx = gw * 64 + F.lane; idx < NS * 32; idx += NGW * 64) {
            const int t = idx >> 5, i = idx & 31;
            double r = (double)t * ROPE_REV[i]; r = r - rint(r);
            const float rf = (float)r;
            cosT[idx] = __builtin_amdgcn_cosf(rf); sinT[idx] = __builtin_amdgcn_sinf(rf);
        }
        if (gw == NGW - 2) {
            float* gains = (float*)(F.ws + WS_GAINS);
            for (int l = 0; l < NL; ++l) {
                gains[(l * 4 + 0) * 64 + F.lane] = F.in[I_GQA][l * 64 + F.lane]; gains[(l * 4 + 1) * 64 + F.lane] = F.in[I_GKA][l * 64 + F.lane];
                gains[(l * 4 + 2) * 64 + F.lane] = F.in[I_GQC][l * 64 + F.lane]; gains[(l * 4 + 3) * 64 + F.lane] = F.in[I_GKC][l * 64 + F.lane];
            }
        }
        if (gw == NGW - 3) {
            float* bnd = (float*)(F.ws + WS_LAM) + 16;
            for (int l = 0; l < NL; ++l) {
                const float qa = wave_max(fabsf(F.in[I_GQA][l * 64 + F.lane])), ka = wave_max(fabsf(F.in[I_GKA][l * 64 + F.lane]));
                const float qc = wave_max(fabsf(F.in[I_GQC][l * 64 + F.lane])), kc = wave_max(fabsf(F.in[I_GKC][l * 64 + F.lane]));
                if (F.lane == 0) { bnd[l * 2] = 64.f * QSCALE * qa * ka * 1.01f + 0.25f; bnd[l * 2 + 1] = 64.f * QSCALE * qc * kc * 1.01f + 0.25f; }
            }
        }
        if (gw == NGW - 1) {
            float* lamv = (float*)(F.ws + WS_LAM);
            for (int l = 0; l < NL; ++l) {
                const float* lp = F.in[I_LAMA] + l * 256;
                const float a = wave_sum(lp[F.lane] * lp[64 + F.lane]);
                const float b = wave_sum(lp[128 + F.lane] * lp[192 + F.lane]);
                const float lam_init = 0.8f - 0.6f * expf(-0.3f * (float)l);
                if (F.lane == 0) { lamv[2 * l] = expf(a) - expf(b) + lam_init; lamv[2 * l + 1] = lam_init; }
            }
        }
    }
    {
        bf16_t* win = (bf16_t*)(F.ws + WS_WIN); bf16_t* wout = (bf16_t*)(F.ws + WS_WOUT); bf16_t* wup = (bf16_t*)(F.ws + WS_WUP); bf16_t* wdn = (bf16_t*)(F.ws + WS_WDN);
        constexpr int I_IN = NL * (ND / 64) * (INW / 32);
        constexpr int I_OUT = NL * (ND / 64) * (ND / 32);
        constexpr int I_UP = NL * NEXP * (ND / 64) * (NF / 32);
        constexpr int I_DN = NL * NEXP * (NF / 64) * (ND / 32);
        constexpr int NITEMS = I_IN + I_OUT + 2 * I_UP + I_DN;
        for (int it = gw; it < NITEMS; it += NGW) {
            int r = it;
            if (r < I_IN) { const int l = r / (I_IN / NL), q = r % (I_IN / NL), kb = q / (INW / 32), nb = q % (INW / 32);
                p0_transpose_item(F.in[I_WIN] + (size_t)l * ND * INW, INW, ND, win + (size_t)l * INW * ND, scr, kb * 64, nb * 32, F.lane, MapIn{}); continue; }
            r -= I_IN;
            if (r < I_OUT) { const int l = r / (I_OUT / NL), q = r % (I_OUT / NL), kb = q / (ND / 32), nb = q % (ND / 32);
                p0_transpose_item(F.in[I_WOUT] + (size_t)l * ND * ND, ND, ND, wout + (size_t)l * ND * ND, scr, kb * 64, nb * 32, F.lane, MapId{}); continue; }
            r -= I_OUT;
            if (r < 2 * I_UP) { const int which = r / I_UP, q0 = r % I_UP, le = q0 / ((ND / 64) * (NF / 32)), q = q0 % ((ND / 64) * (NF / 32)), kb = q / (NF / 32), nb = q % (NF / 32);
                p0_transpose_item(F.in[which ? I_W3 : I_W1] + (size_t)le * ND * NF, NF, ND, wup + (size_t)le * 512 * ND, scr, kb * 64, nb * 32, F.lane, MapUp{which}); continue; }
            r -= 2 * I_UP;
            { const int le = r / ((NF / 64) * (ND / 32)), q = r % ((NF / 64) * (ND / 32)), kb = q / (ND / 32), nb = q % (ND / 32);
                p0_transpose_item(F.in[I_W2] + (size_t)le * NF * ND, ND, NF, wdn + (size_t)le * ND * NF, scr, kb * 64, nb * 32, F.lane, MapId{}); }
        }
    }
}

template <int COMBINE, int WRITE_H>
__device__ __forceinline__ void ln_rows(Frame& F, const float* x, float* xw, const bf16_t* ym, const float* ga2  , const float* g, const float* modl, int sh_off, int sc_off, bf16_t* h) {
    const int gw = F.vcu * NWAVES + F.wave, NGW = F.G * NWAVES;
    for (int row = gw; row < NT; row += NGW) {
        const int b = row / NS;
        const f32x4* xr = (const f32x4*)(x + (size_t)row * ND) + F.lane;
        f32x4 v[4]; float ss = 0.f;
#pragma unroll
        for (int j = 0; j < 4; ++j) v[j] = xr[64 * j];
        if (COMBINE) {
            const u32x2* y0 = (const u32x2*)(ym + (size_t)row * 2048) + F.lane;
#pragma unroll
            for (int j = 0; j < 4; ++j) { const u32x2 a = y0[64 * j], c = y0[256 + 64 * j];
                const f32x4 gt = *(const f32x4*)(ga2 + (size_t)b * NMOD + (F.lane + 64 * j) * 4);
                v[j][0] += gt[0] * (__uint_as_float(a.x << 16) + __uint_as_float(c.x << 16)); v[j][1] += gt[1] * (__uint_as_float(a.x & 0xffff0000u) + __uint_as_float(c.x & 0xffff0000u));
                v[j][2] += gt[2] * (__uint_as_float(a.y << 16) + __uint_as_float(c.y << 16)); v[j][3] += gt[3] * (__uint_as_float(a.y & 0xffff0000u) + __uint_as_float(c.y & 0xffff0000u));
                ((f32x4*)(xw + (size_t)row * ND) + F.lane)[64 * j] = v[j]; }
        }
        if (WRITE_H) {
#pragma unroll
            for (int j = 0; j < 4; ++j) ss += (v[j][0] * v[j][0] + v[j][1] * v[j][1]) + (v[j][2] * v[j][2] + v[j][3] * v[j][3]);
            ss = wave_sum(ss);
            const float rstd = 1.0f / sqrtf(ss * (1.f / ND) + EPS);
            const float* mb = modl + (size_t)b * NMOD;
            u32x2* o8 = (u32x2*)(h + (size_t)row * ND) + F.lane;
#pragma unroll
            for (int j = 0; j < 4; ++j) {
                const int d = (F.lane + 64 * j) * 4;
                const f32x4 gg = *(const f32x4*)(g + d), sc = *(const f32x4*)(mb + sc_off + d), sh = *(const f32x4*)(mb + sh_off + d);
                const f32x4 o = v[j] * rstd * gg * (sc + 1.0f) + sh;
                u32x2 w; w.x = pk2(o[0], o[1]); w.y = pk2(o[2], o[3]); o8[64 * j] = w;
            }
        }
    }
}

__device__ __forceinline__ void router_phase(Frame& F, int l, const float* x, const float* modl, bf16_t* h) {
    const int gw = F.vcu * NWAVES + F.wave, NGW = F.G * NWAVES;
    const float* g = F.in[I_GN2] + l * ND;
    const float* w_rg = F.in[I_WRG] + (size_t)l * ND * 4; const float* b_rg = F.in[I_BRG] + l * 4;
    const float* w_re = F.in[I_WRE] + (size_t)l * 4 * ND * 8; const float* b_re = F.in[I_BRE] + l * 32;
    LAS int* lcnt = (LAS int*)(F.lds + TAB_OFF);
    if (F.tid < 64) lcnt[F.tid] = 0;
    __syncthreads();
    int my_e = -1, my_row2 = 0, my_rank = 0; float my_w = 0.f;
    int it = 0;
    for (int row = gw; row < NT; row += NGW, ++it) {
        const int b = row / NS;
        const f32x4* xr = (const f32x4*)(x + (size_t)row * ND) + F.lane;
        f32x4 v[4]; float ss = 0.f;
#pragma unroll
        for (int j = 0; j < 4; ++j) { v[j] = xr[64 * j]; ss += (v[j][0] * v[j][0] + v[j][1] * v[j][1]) + (v[j][2] * v[j][2] + v[j][3] * v[j][3]); }
        ss = wave_sum(ss);
        const float rstd = 1.0f / sqrtf(ss * (1.f / ND) + EPS);
        const float* mb = modl + (size_t)b * NMOD;
        u32x2* o8 = (u32x2*)(h + (size_t)row * ND) + F.lane;
        float gl[4] = {0.f, 0.f, 0.f, 0.f};
#pragma unroll
        for (int j = 0; j < 4; ++j) {
            const int d = (F.lane + 64 * j) * 4;
            const f32x4 gg = *(const f32x4*)(g + d), sc = *(const f32x4*)(mb + 4096 + d), sh = *(const f32x4*)(mb + 3072 + d);
            v[j] = v[j] * rstd * gg * (sc + 1.0f) + sh;
            u32x2 w; w.x = pk2(v[j][0], v[j][1]); w.y = pk2(v[j][2], v[j][3]); o8[64 * j] = w;
#pragma unroll
            for (int q = 0; q < 4; ++q) { const f32x4 wr = *(const f32x4*)(w_rg + (size_t)(d + q) * 4);
                gl[0] += v[j][q] * wr[0]; gl[1] += v[j][q] * wr[1]; gl[2] += v[j][q] * wr[2]; gl[3] += v[j][q] * wr[3]; }
        }
#pragma unroll
        for (int gi = 0; gi < 4; ++gi) gl[gi] = wave_sum(gl[gi]) + b_rg[gi];
        int gidx = 0; float gm = gl[0];
#pragma unroll
        for (int gi = 1; gi < 4; ++gi) if (gl[gi] > gm) { gm = gl[gi]; gidx = gi; }
        float gs = 0.f;
#pragma unroll
        for (int gi = 0; gi < 4; ++gi) gs += expf(gl[gi] - gm);
        const float g_w = 1.0f / gs;
        float el[8] = {0.f, 0.f, 0.f, 0.f, 0.f, 0.f, 0.f, 0.f};
        const float* wre = w_re + (size_t)gidx * ND * 8;
#pragma unroll
        for (int j = 0; j < 4; ++j) {
            const int d = (F.lane + 64 * j) * 4;
#pragma unroll
            for (int q = 0; q < 4; ++q) { const f32x4 w0 = *(const f32x4*)(wre + (size_t)(d + q) * 8), w1 = *(const f32x4*)(wre + (size_t)(d + q) * 8 + 4);
                el[0] += v[j][q] * w0[0]; el[1] += v[j][q] * w0[1]; el[2] += v[j][q] * w0[2]; el[3] += v[j][q] * w0[3];
                el[4] += v[j][q] * w1[0]; el[5] += v[j][q] * w1[1]; el[6] += v[j][q] * w1[2]; el[7] += v[j][q] * w1[3]; }
        }
#pragma unroll
        for (int e = 0; e < 8; ++e) el[e] = wave_sum(el[e]) + b_re[gidx * 8 + e];
        int i0 = 0; float v0 = el[0];
#pragma unroll
        for (int e = 1; e < 8; ++e) if (el[e] > v0) { v0 = el[e]; i0 = e; }
        int i1 = -1; float v1 = -INFINITY;
#pragma unroll
        for (int e = 0; e < 8; ++e) if (e != i0 && el[e] > v1) { v1 = el[e]; i1 = e; }
        const float e1 = expf(v1 - v0);
        const float w0 = g_w / (1.0f + e1), w1 = g_w * e1 / (1.0f + e1);
        if (F.lane == 2 * it) { my_e = gidx * 8 + i0; my_row2 = row * 2; my_w = w0; }
        if (F.lane == 2 * it + 1) { my_e = gidx * 8 + i1; my_row2 = row * 2 + 1; my_w = w1; }
    }
    if (my_e >= 0) my_rank = __hip_atomic_fetch_add(lcnt + my_e, 1, __ATOMIC_RELAXED, __HIP_MEMORY_SCOPE_WORKGROUP);
    __syncthreads();
    if (F.tid < 32) { const int c = lcnt[F.tid]; int basev = 0;
        if (c > 0) basev = (int)__hip_atomic_fetch_add((unsigned*)(F.ws + WS_CTL) + CW_CNT + (l * 32 + F.tid) * 64, (unsigned)c, __ATOMIC_RELAXED, __HIP_MEMORY_SCOPE_AGENT);
        lcnt[32 + F.tid] = basev; }
    __syncthreads();
    if (my_e >= 0) {
        const int pos = lcnt[32 + my_e] + my_rank;
        ((int*)(F.ws + WS_PERM))[my_e * 16384 + pos] = my_row2;
        ((float*)(F.ws + WS_SELW))[my_row2] = my_w;
    }
    __syncthreads();
}

constexpr int TAB_ROWS_OFF = TAB_OFF + 512, TAB_ROWS2_OFF = TAB_OFF + 512 + 4096;
__device__ __forceinline__ int build_group_tables(Frame& F, int l, int npn, int first, bool up) {
    LAS int* tab = (LAS int*)(F.lds + TAB_OFF);
    int tid = threadIdx.x; asm volatile("" : "+v"(tid));
    const unsigned* cntw = (const unsigned*)(F.ws + WS_CTL) + CW_CNT + (size_t)l * 32 * 64;
    __syncthreads();
    if (tid < 32) tab[16 + tid] = (int)__hip_atomic_load(cntw + tid * 64, __ATOMIC_RELAXED, __HIP_MEMORY_SCOPE_AGENT);
    __syncthreads();
    if (tid == 0) { int acc = 0; for (int e = 0; e < 32; ++e) { tab[48 + e] = acc; acc += (tab[16 + e] + 255) >> 8; } tab[80] = acc; }
    __syncthreads();
    const int U = tab[80] * npn;
    int n_local = 0;
    for (int i = 0; i < 4; ++i) {
        const int gi = F.vcu + (first + i) * F.G;
        if (gi >= U) break;
        n_local = i + 1;
        const int mtg = gi / npn, pn = gi % npn;
        int e = 0;
        for (int q = 1; q < 32; ++q) if (tab[48 + q] <= mtg) e = q;
        while (e > 0 && ((tab[16 + e] + 255) >> 8) == 0) --e;
        const int mt = mtg - tab[48 + e], cnt = tab[16 + e];
        if (tid == 0) { tab[i * 4] = mtg; tab[i * 4 + 1] = e * npn + pn; tab[i * 4 + 2] = min(256, cnt - mt * 256); tab[i * 4 + 3] = e; }
        if (tid < 256) {
            const int idx = mt * 256 + tid; const bool valid = idx < cnt;
            const int entry = valid ? ((const int*)(F.ws + WS_PERM))[e * 16384 + idx] : 0;
            if (up) ((LAS unsigned*)(F.lds + TAB_ROWS_OFF))[i * 256 + tid] = (unsigned)(entry >> 1) * (unsigned)(ND * 2);
            else { ((LAS int*)(F.lds + TAB_ROWS_OFF))[i * 256 + tid] = valid ? entry : -1; ((LAS float*)(F.lds + TAB_ROWS2_OFF))[i * 256 + tid] = valid ? ((const float*)(F.ws + WS_SELW))[entry] : 0.f; }
        }
    }
    __syncthreads();
    return n_local;
}

namespace mix {
typedef short s16x4 __attribute__((ext_vector_type(4)));
__device__ __forceinline__ int crow(int r, int hi) { return (r & 3) + 8 * (r >> 2) + 4 * hi; }
__device__ __forceinline__ s16x4 vtr(const LAS unsigned char* p) { return __builtin_bit_cast(s16x4, __builtin_amdgcn_ds_read_tr16_b64_v4i16((LAS s16x4*)p)); }
__device__ __forceinline__ unsigned cvtpk(float lo, float hi) { unsigned r; asm volatile("v_cvt_pk_bf16_f32 %0, %1, %2" : "=v"(r) : "v"(lo), "v"(hi)); return r; }
#define MIX_MFMA32(a, b, c) __builtin_amdgcn_mfma_f32_32x32x16_bf16((a), (b), (c), 0, 0, 0)

constexpr int DA_STAGE = 65536, DA_K1 = 16384, DA_V = 32768;
__device__ __forceinline__ void da_stage_load(LAS unsigned char* lds, int buf, const bf16_t* Zb, int h, int key0, int wave, int lane) {
#pragma unroll
    for (int i = 0; i < 8; ++i) {
        const int p = wave * 8 + i;
        const bf16_t* src; int dst;
        if (p < 32) { const int m = p >> 4, q = p & 15, kp = q >> 3, c = q & 7;
            src = Zb + (size_t)(key0 + kp * 64 + lane) * INW + 512 + h * 128 + m * 64 + c * 8;
            dst = buf * DA_STAGE + m * DA_K1 + kp * 8192 + c * 1024; }
        else { const int q = p - 32, kp = q >> 4, dvb = (q >> 2) & 3, rg = q & 3;
            src = Zb + (size_t)(key0 + kp * 64 + rg * 16 + (lane >> 2)) * INW + 1024 + h * 128 + dvb * 32 + (lane & 3) * 8;
            dst = buf * DA_STAGE + DA_V + kp * 16384 + dvb * 4096 + rg * 1024; }
        __builtin_amdgcn_global_load_lds((const unsigned*)src, (LAS unsigned*)(lds + dst), 16, 0, 0);
    }
}

__device__ __forceinline__ void da_unit(Frame& F, int b, int h, int j, const bf16_t* Z, bf16_t* ycat, float lam, float omli, float negCb, const float* gsub) {
    LAS unsigned char* lds = F.lds;
    const int lane = F.lane, wave = F.wave, r32 = lane & 31, hi = lane >> 5, qsub = wave & 3, m = wave >> 2;
    const bf16_t* Zb = Z + (size_t)b * NS * INW;
    const int vrd = ((lane >> 4) & 1) * 32 + (lane & 3) * 8 + (4 * hi + ((lane & 15) >> 2)) * 64;
#pragma unroll 1
    for (int half = 0; half < 2; ++half) {
        const int qb = half ? (15 - j) : j, q0 = qb * 128, nsteps = qb + 1;
        da_stage_load(lds, 0, Zb, h, 0, wave, lane);
        bf16x8 qr[4];
        { const bf16_t* qp = Zb + (size_t)(q0 + qsub * 32 + r32) * INW + h * 128 + m * 64 + hi * 8;
#pragma unroll
          for (int d0 = 0; d0 < 4; ++d0) qr[d0] = *(const bf16x8*)(qp + d0 * 16); }
        f32x16 O[4];
#pragma unroll
        for (int d = 0; d < 4; ++d)
#pragma unroll
            for (int r = 0; r < 16; ++r) O[d][r] = 0.f;
        float lsum = 0.f;
#pragma unroll 1
        for (int s = 0; s < nsteps; ++s) {
            const int buf = s & 1;
            if (s + 1 < nsteps) { da_stage_load(lds, buf ^ 1, Zb, h, (s + 1) * 128, wave, lane); asm volatile("s_waitcnt vmcnt(8)" ::: "memory"); }
            else asm volatile("s_waitcnt vmcnt(0)" ::: "memory");
            __builtin_amdgcn_s_barrier(); asm volatile("" ::: "memory");
            const bool diag = (s == qb);
#pragma unroll 1
            for (int kp = 0; kp < 2; ++kp) {
                if (diag && kp == 1 && qsub < 2) break;
                const LAS unsigned char* kb = lds + buf * DA_STAGE + m * DA_K1 + kp * 8192 + hi * 1024 + r32 * 16;
                const LAS unsigned char* vb = lds + buf * DA_STAGE + DA_V + kp * 16384 + vrd;
                f32x16 s0, s1;
#pragma unroll
                for (int r = 0; r < 16; ++r) { s0[r] = negCb; s1[r] = negCb; }
#pragma unroll
                for (int d0 = 0; d0 < 4; ++d0) {
                    const bf16x8 k0 = *(const LAS bf16x8*)(kb + d0 * 2048);
                    const bf16x8 k1 = *(const LAS bf16x8*)(kb + d0 * 2048 + 512);
                    s0 = MIX_MFMA32(k0, qr[d0], s0); s1 = MIX_MFMA32(k1, qr[d0], s1);
                }
                if (diag) {
                    const int qrel = qsub * 32 + r32, kbase = kp * 64 + 4 * hi;
#pragma unroll
                    for (int r = 0; r < 16; ++r) { const int kv = kbase + (r & 3) + 8 * (r >> 2); if (kv > qrel) s0[r] = -INFINITY; if (kv + 32 > qrel) s1[r] = -INFINITY; }
                }
                float ls = 0.f;
#pragma unroll
                for (int r = 0; r < 16; ++r) { s0[r] = __builtin_amdgcn_exp2f(s0[r]); s1[r] = __builtin_amdgcn_exp2f(s1[r]); ls += s0[r] + s1[r]; }
                lsum += ls;
                bf16x8 pa[4];
                { u32x4 w0, w1, w2, w3;
                  w0 = (u32x4){cvtpk(s0[0], s0[1]), cvtpk(s0[2], s0[3]), cvtpk(s0[4], s0[5]), cvtpk(s0[6], s0[7])};
                  w1 = (u32x4){cvtpk(s0[8], s0[9]), cvtpk(s0[10], s0[11]), cvtpk(s0[12], s0[13]), cvtpk(s0[14], s0[15])};
                  w2 = (u32x4){cvtpk(s1[0], s1[1]), cvtpk(s1[2], s1[3]), cvtpk(s1[4], s1[5]), cvtpk(s1[6], s1[7])};
                  w3 = (u32x4){cvtpk(s1[8], s1[9]), cvtpk(s1[10], s1[11]), cvtpk(s1[12], s1[13]), cvtpk(s1[14], s1[15])};
                  pa[0] = __builtin_bit_cast(bf16x8, w0); pa[1] = __builtin_bit_cast(bf16x8, w1); pa[2] = __builtin_bit_cast(bf16x8, w2); pa[3] = __builtin_bit_cast(bf16x8, w3); }
#pragma unroll
                for (int dvb = 0; dvb < 4; ++dvb) {
                    bf16x8 vf[4];
#pragma unroll
                    for (int ks = 0; ks < 4; ++ks) { const s16x4 lo = vtr(vb + dvb * 4096 + ks * 1024), hh = vtr(vb + dvb * 4096 + ks * 1024 + 512);
                        vf[ks] = (bf16x8){lo[0], lo[1], lo[2], lo[3], hh[0], hh[1], hh[2], hh[3]}; }
#pragma unroll
                    for (int ks = 0; ks < 4; ++ks) O[dvb] = MIX_MFMA32(pa[ks], vf[ks], O[dvb]);
                }
            }
            asm volatile("s_waitcnt lgkmcnt(0)" ::: "memory");
            __builtin_amdgcn_s_barrier(); asm volatile("" ::: "memory");
        }
        lsum = xor32_sum(lsum);
        LAS float* Wq = (LAS float*)(lds + TAB_OFF) + wave * 32;
        if (hi == 0) Wq[r32] = (m == 0) ? (1.0f / lsum) : (lam / lsum);
        asm volatile("s_waitcnt lgkmcnt(0)" ::: "memory");
        float sc[16];
#pragma unroll
        for (int r = 0; r < 16; ++r) sc[r] = Wq[crow(r, hi)];
        LAS unsigned char* X = lds + (size_t)qsub * 16384 + lane * 64;
        if (m == 1) {
#pragma unroll
            for (int dvb = 0; dvb < 4; ++dvb)
#pragma unroll
                for (int q4 = 0; q4 < 4; ++q4) *(LAS f32x4*)(X + dvb * 4096 + q4 * 16) = (f32x4){O[dvb][q4 * 4] * sc[q4 * 4], O[dvb][q4 * 4 + 1] * sc[q4 * 4 + 1], O[dvb][q4 * 4 + 2] * sc[q4 * 4 + 2], O[dvb][q4 * 4 + 3] * sc[q4 * 4 + 3]};
        }
        asm volatile("s_waitcnt lgkmcnt(0)" ::: "memory");
        __builtin_amdgcn_s_barrier(); asm volatile("" ::: "memory");
        if (m == 0) {
            float ss[16];
#pragma unroll
            for (int r = 0; r < 16; ++r) ss[r] = 0.f;
#pragma unroll
            for (int dvb = 0; dvb < 4; ++dvb)
#pragma unroll
                for (int q4 = 0; q4 < 4; ++q4) {
                    const f32x4 x1 = *(const LAS f32x4*)(X + dvb * 4096 + q4 * 16);
#pragma unroll
                    for (int e = 0; e < 4; ++e) { const int r = q4 * 4 + e; const float o = O[dvb][r] * sc[r] - x1[e]; O[dvb][r] = o; ss[r] += o * o; }
                }
#pragma unroll
            for (int r = 0; r < 16; ++r) { float v = ss[r]; v += dpp_f<0xB1>(v); v += dpp_f<0x4E>(v); v += dpp_f<0x141>(v); v += dpp_f<0x140>(v); v += xor16_f(v);
                ss[r] = omli / sqrtf(v * (1.f / 128.f) + EPS); }
            asm volatile("s_waitcnt lgkmcnt(0)" ::: "memory");
            LAS bf16_t* stg = (LAS bf16_t*)(lds + (size_t)qsub * 16384);
#pragma unroll
            for (int dvb = 0; dvb < 4; ++dvb) { const float gs = gsub[dvb * 32 + r32];
#pragma unroll
                for (int r = 0; r < 16; ++r) stg[crow(r, hi) * 128 + dvb * 32 + r32] = f2bf(O[dvb][r] * ss[r] * gs); }
            asm volatile("s_waitcnt lgkmcnt(0)" ::: "memory");
            bf16_t* yo = ycat + (size_t)(b * NS + q0 + qsub * 32) * ND + h * 128;
#pragma unroll
            for (int i = 0; i < 8; ++i) { const int row = i * 4 + (lane >> 4), ch = lane & 15;
                const u32x4 v = *(const LAS u32x4*)(stg + row * 128 + ch * 8); *(u32x4*)(yo + (size_t)row * ND + ch * 8) = v; }
        }
        asm volatile("s_waitcnt lgkmcnt(0)" ::: "memory");
        __builtin_amdgcn_s_barrier(); asm volatile("" ::: "memory");
    }
}

constexpr int DL_ACC = 65536;
__device__ __forceinline__ void dil_span(Frame& F, int b, int h, int sp, const bf16_t* Z, bf16_t* ycat, float negCb) {
    LAS unsigned char* lds = F.lds;
    const int lane = F.lane, wave = F.wave, r32 = lane & 31, hi = lane >> 5, tid = F.tid;
    const bf16_t* Zb = Z + (size_t)b * NS * INW;
    const int P0 = sp * 256;
    LAS float* Oacc = (LAS float*)(lds + DL_ACC); LAS float* Lacc = (LAS float*)(lds + TAB_OFF);
    for (int i = tid; i < 256 * 64; i += NWAVES * 64) Oacc[i] = 0.f;
    if (tid < 256) Lacc[tid] = 0.f;
    asm volatile("s_waitcnt lgkmcnt(0)" ::: "memory");
    __builtin_amdgcn_s_barrier(); asm volatile("" ::: "memory");
    LAS unsigned char* vt = lds + wave * 8192;
    const int vrd = ((lane >> 4) & 1) * 32 + (lane & 3) * 8 + (4 * hi + ((lane & 15) >> 2)) * 64;
#pragma unroll 1
    for (int k = 0; k < 4; ++k) {
        int sh, r, j0, nvalid;
        if (k == 0) { sh = 0; r = 0; j0 = P0 + 32 * wave; nvalid = 32; }
        else if (k == 1) { sh = 2; r = wave >> 1; j0 = (P0 >> 2) + 32 * (wave & 1); nvalid = 32; }
        else { sh = 4; r = 2 * wave + (k - 2); j0 = P0 >> 4; nvalid = 16; }
        const int Lm1 = (NS >> sh) - 1;
        bf16x8 qr[4];
        { const int jq = min(j0 + r32, Lm1);
          const bf16_t* qp = Zb + (size_t)(r + (jq << sh)) * INW + 1792 + h * 64 + hi * 8;
#pragma unroll
          for (int d0 = 0; d0 < 4; ++d0) qr[d0] = *(const bf16x8*)(qp + d0 * 16); }
        f32x16 O[2];
#pragma unroll
        for (int d = 0; d < 2; ++d)
#pragma unroll
            for (int rr = 0; rr < 16; ++rr) O[d][rr] = 0.f;
        float lsum = 0.f;
        const int T0 = max(j0 - 128, 0) >> 6, T1 = (j0 + nvalid - 1) >> 6;
#pragma unroll 1
        for (int T = T0; T <= T1; ++T) {
            { u32x4 vv[8];
#pragma unroll
              for (int blk = 0; blk < 8; ++blk) { const int dvb = blk >> 2, rg = blk & 3; const int jk = min(64 * T + 16 * rg + (lane >> 2), Lm1);
                  vv[blk] = *(const u32x4*)(Zb + (size_t)(r + (jk << sh)) * INW + 2304 + h * 64 + dvb * 32 + (lane & 3) * 8); }
#pragma unroll
              for (int blk = 0; blk < 8; ++blk) *(LAS u32x4*)(vt + blk * 1024 + lane * 16) = vv[blk]; }
            f32x16 s0, s1;
#pragma unroll
            for (int rr = 0; rr < 16; ++rr) { s0[rr] = negCb; s1[rr] = negCb; }
            { const int jk0 = min(64 * T + r32, Lm1), jk1 = min(64 * T + 32 + r32, Lm1);
              const bf16_t* kp0 = Zb + (size_t)(r + (jk0 << sh)) * INW + 2048 + h * 64 + hi * 8;
              const bf16_t* kp1 = Zb + (size_t)(r + (jk1 << sh)) * INW + 2048 + h * 64 + hi * 8;
#pragma unroll
              for (int d0 = 0; d0 < 4; ++d0) { const bf16x8 k0 = *(const bf16x8*)(kp0 + d0 * 16), k1 = *(const bf16x8*)(kp1 + d0 * 16);
                  s0 = MIX_MFMA32(k0, qr[d0], s0); s1 = MIX_MFMA32(k1, qr[d0], s1); } }
            { const int jq = j0 + r32, kb = 64 * T + 4 * hi; const bool rowok = r32 < nvalid;
#pragma unroll
              for (int rr = 0; rr < 16; ++rr) { const int jk = kb + (rr & 3) + 8 * (rr >> 2);
                  const int dd0 = jq - jk, dd1 = dd0 - 32;
                  if (!(rowok && dd0 >= 0 && dd0 <= 128)) s0[rr] = -INFINITY;
                  if (!(rowok && dd1 >= 0 && dd1 <= 128)) s1[rr] = -INFINITY; } }
            float ls = 0.f;
#pragma unroll
            for (int rr = 0; rr < 16; ++rr) { s0[rr] = __builtin_amdgcn_exp2f(s0[rr]); s1[rr] = __builtin_amdgcn_exp2f(s1[rr]); ls += s0[rr] + s1[rr]; }
            lsum += ls;
            bf16x8 pa[4];
            { u32x4 w0, w1, w2, w3;
              w0 = (u32x4){cvtpk(s0[0], s0[1]), cvtpk(s0[2], s0[3]), cvtpk(s0[4], s0[5]), cvtpk(s0[6], s0[7])};
              w1 = (u32x4){cvtpk(s0[8], s0[9]), cvtpk(s0[10], s0[11]), cvtpk(s0[12], s0[13]), cvtpk(s0[14], s0[15])};
              w2 = (u32x4){cvtpk(s1[0], s1[1]), cvtpk(s1[2], s1[3]), cvtpk(s1[4], s1[5]), cvtpk(s1[6], s1[7])};
              w3 = (u32x4){cvtpk(s1[8], s1[9]), cvtpk(s1[10], s1[11]), cvtpk(s1[12], s1[13]), cvtpk(s1[14], s1[15])};
              pa[0] = __builtin_bit_cast(bf16x8, w0); pa[1] = __builtin_bit_cast(bf16x8, w1); pa[2] = __builtin_bit_cast(bf16x8, w2); pa[3] = __builtin_bit_cast(bf16x8, w3); }
#pragma unroll
            for (int dvb = 0; dvb < 2; ++dvb) {
#pragma unroll
                for (int ks = 0; ks < 4; ++ks) { const s16x4 lo = vtr(vt + vrd + dvb * 4096 + ks * 1024), hh = vtr(vt + vrd + dvb * 4096 + ks * 1024 + 512);
                    const bf16x8 vf = (bf16x8){lo[0], lo[1], lo[2], lo[3], hh[0], hh[1], hh[2], hh[3]};
                    O[dvb] = MIX_MFMA32(pa[ks], vf, O[dvb]); }
            }
            asm volatile("s_waitcnt lgkmcnt(0)" ::: "memory");
        }
        lsum = xor32_sum(lsum);
        { const int prel = r + ((j0 + r32) << sh) - P0;
          if (hi == 0 && r32 < nvalid) __hip_atomic_fetch_add(Lacc + prel, lsum, __ATOMIC_RELAXED, __HIP_MEMORY_SCOPE_WORKGROUP); }
#pragma unroll
        for (int rr = 0; rr < 16; ++rr) { const int row = crow(rr, hi);
            if (row < nvalid) { const int prel = r + ((j0 + row) << sh) - P0;
#pragma unroll
                for (int dvb = 0; dvb < 2; ++dvb) __hip_atomic_fetch_add(Oacc + prel * 64 + dvb * 32 + r32, O[dvb][rr], __ATOMIC_RELAXED, __HIP_MEMORY_SCOPE_WORKGROUP); } }
    }
    asm volatile("s_waitcnt lgkmcnt(0)" ::: "memory");
    __builtin_amdgcn_s_barrier(); asm volatile("" ::: "memory");
    { const int pos = tid >> 1, dh = (tid & 1) * 32;
      const float inv = 1.0f / Lacc[pos];
      bf16_t* yo = ycat + (size_t)(b * NS + P0 + pos) * ND + 768 + h * 64 + dh;
#pragma unroll
      for (int c4 = 0; c4 < 4; ++c4) { const f32x4 a = *(const LAS f32x4*)(Oacc + pos * 64 + dh + c4 * 8), c = *(const LAS f32x4*)(Oacc + pos * 64 + dh + c4 * 8 + 4);
          u32x4 w; w.x = cvtpk(a[0] * inv, a[1] * inv); w.y = cvtpk(a[2] * inv, a[3] * inv); w.z = cvtpk(c[0] * inv, c[1] * inv); w.w = cvtpk(c[2] * inv, c[3] * inv);
          *(u32x4*)(yo + c4 * 8) = w; } }
    asm volatile("s_waitcnt lgkmcnt(0)" ::: "memory");
    __builtin_amdgcn_s_barrier(); asm volatile("" ::: "memory");
}

constexpr int PL_PITCH = 528;
__device__ __forceinline__ void pool_tile(Frame& F, int tile, const bf16_t* Z, bf16_t* ycat, const float* w_pool, const float* b_pool, const float* pool_scale) {
    LAS unsigned char* lds = F.lds;
    const int lane = F.lane, wave = F.wave, r32 = lane & 31, hi = lane >> 5, tid = F.tid;
    const int row0 = tile * 64, pos0 = row0 & (NS - 1);
    {
        const int c = tid & 255, th = tid >> 8, g = c >> 6, win = 2 << g;
        const int ps = pos0 + 32 * th;
        const bf16_t* up = Z + (size_t)(row0 - pos0) * INW + 1536 + c;
        float s = 0.f;
        for (int p = max(ps - win, 0); p < ps; ++p) s += bf2f(up[(size_t)p * INW]);
#pragma unroll 4
        for (int i = 0; i < 32; ++i) {
            const int p = ps + i;
            const float u = bf2f(up[(size_t)p * INW]);
            s += u;
            if (p - win >= 0) s -= bf2f(up[(size_t)(p - win) * INW]);
            const float cnt = (float)min(p + 1, win);
            *(LAS bf16_t*)(lds + (32 * th + i) * PL_PITCH + c * 2) = f2bf(s / cnt - u);
        }
    }
    asm volatile("s_waitcnt lgkmcnt(0)" ::: "memory");
    __builtin_amdgcn_s_barrier(); asm volatile("" ::: "memory");
    {
        const int g = wave >> 1, mb = wave & 1;
        bf16x8 af[4];
#pragma unroll
        for (int ks = 0; ks < 4; ++ks) af[ks] = *(const LAS bf16x8*)(lds + (32 * mb + r32) * PL_PITCH + (64 * g + 16 * ks + 8 * hi) * 2);
#pragma unroll
        for (int nb = 0; nb < 2; ++nb) {
            f32x16 acc;
#pragma unroll
            for (int rr = 0; rr < 16; ++rr) acc[rr] = 0.f;
            const int e = 32 * nb + r32;
#pragma unroll
            for (int ks = 0; ks < 4; ++ks) {
                const float* wp = w_pool + g * 4096 + (16 * ks + 8 * hi) * 64 + e;
                u32x4 w; w.x = pk2(wp[0], wp[64]); w.y = pk2(wp[128], wp[192]); w.z = pk2(wp[256], wp[320]); w.w = pk2(wp[384], wp[448]);
                acc = MIX_MFMA32(af[ks], __builtin_bit_cast(bf16x8, w), acc);
            }
            const float bb = b_pool[g * 64 + e], ps = pool_scale[g * 64 + e];
            bf16_t* yo = ycat + (size_t)(row0 + 32 * mb) * ND + 512 + 64 * g + e;
#pragma unroll
            for (int rr = 0; rr < 16; ++rr) yo[(size_t)crow(rr, hi) * ND] = f2bf((acc[rr] + bb) * ps);
        }
    }
    asm volatile("s_waitcnt lgkmcnt(0)" ::: "memory");
    __builtin_amdgcn_s_barrier(); asm volatile("" ::: "memory");
}
#undef MIX_MFMA32
}

constexpr int PH_FINAL = 15, PH_END = 16;
__global__ void __launch_bounds__(NWAVES * 64, 2) fwd_kernel(Params P) {
    extern __shared__ __attribute__((aligned(16))) unsigned char lds_raw[];
    Frame F;
    F.lds = (LAS unsigned char*)lds_raw;
    F.tid = threadIdx.x; F.lane = F.tid & 63; F.wave = __builtin_amdgcn_readfirstlane(F.tid >> 6);
    F.G = gridDim.x; { const int bx = blockIdx.x; F.vcu = (F.G % 8 == 0) ? (bx % 8) * (F.G / 8) + bx / 8 : bx; }
    F.in = P.in; F.out = P.out; F.ws = P.ws;
    volatile LAS unsigned* MISC = (volatile LAS unsigned*)(F.lds + MISC_OFF);
    if (F.tid < 64) MISC[F.tid] = 0u;
    __syncthreads();
    unsigned* ctl = (unsigned*)(P.ws + WS_CTL);
    const int lo = P.ph_lo, hi = P.ph_hi;
    const bool multi = (hi - lo) > 1;
    XcdBarrier bar; bar.bar = ctl + CW_BAR; bar.x = 0; bar.st = nullptr;
    if (multi) bar = xcd_barrier_post(ctl + CW_BAR, MISC + 8);
#ifdef ONLY_PHASE
#define IN(k) ((((k) == 0 || (k) == PH_FINAL) ? (k) : (((k) - 1) % 7 + 1)) == ONLY_PHASE && lo <= (k) && (k) < hi)
#else
#define IN(k) (lo <= (k) && (k) < hi)
#endif
#define SEAM(k) do { if (IN(k) && IN((k) + 1)) xcd_barrier(bar); } while (0)
#define FRESH() do { int t_ = threadIdx.x; asm volatile("" : "+v"(t_)); F.tid = t_; F.lane = t_ & 63; F.wave = __builtin_amdgcn_readfirstlane(t_ >> 6); \
        unsigned char* w_ = P.ws; asm volatile("" : "+s"(w_)); F.ws = w_; mod = (float*)(w_ + WS_MOD); HB = (bf16_t*)(w_ + WS_HB); ZB = (bf16_t*)(w_ + WS_ZB); YM = ZB; } while (0)
    float* mod; bf16_t *HB, *ZB, *YM;

    if (IN(0)) { FRESH(); p0_prologue(F); }
    SEAM(0);
    for (int l = 0; l < NL; ++l) {
        const int base = 1 + 7 * l;
        if (IN(base + 0)) { FRESH(); const float* modl = mod + (size_t)l * NB * NMOD;
            if (l == 0) ln_rows<0, 1>(F, P.in[I_X], nullptr, nullptr, nullptr, P.in[I_GN1] + l * ND, modl, 0, 1024, HB);
            else        ln_rows<1, 1>(F, P.out, P.out, YM, mod + (size_t)(l - 1) * NB * NMOD + 5120, P.in[I_GN1] + l * ND, modl, 0, 1024, HB);
        }
        SEAM(base + 0);
        if (IN(base + 1)) { FRESH();
            pg8::Gemm g{HB, (const bf16_t*)(F.ws + WS_WIN) + (size_t)l * INW * ND, ND};
            pg8::StaticOrder S; S.init(NT, INW, F.G, (int)blockIdx.x);
            pg8::EpiInProj E{ZB, (const float*)(F.ws + WS_GAINS) + l * 256, (const float*)(F.ws + WS_COS), (const float*)(F.ws + WS_SIN)};
            pg8::gemm_phase<pg8::EpiInProj, pg8::StaticOrder, true, false>(F.lds, F.tid, g, S, E);
        }
        SEAM(base + 1);
        if (IN(base + 2)) { FRESH();
            const float* lamv = (const float*)(F.ws + WS_LAM);
            const float lam = lamv[2 * l], omli = 1.0f - lamv[2 * l + 1], negCb = -lamv[16 + 2 * l];
            for (int u = F.vcu; u < NB * 4 * 8; u += F.G)
                mix::da_unit(F, u >> 5, (u >> 3) & 3, u & 7, ZB, HB, lam, omli, negCb, P.in[I_GSUBA] + l * 128);
            { const float negCc = -lamv[16 + 2 * l + 1];
              for (int u = F.vcu; u < NB * 4 * 8; u += F.G) mix::dil_span(F, u >> 5, (u >> 3) & 3, u & 7, ZB, HB, negCc); }
            for (int u = F.vcu; u < NT / 64; u += F.G) mix::pool_tile(F, u, ZB, HB, P.in[I_WPOOL] + l * 16384, P.in[I_BPOOL] + l * 256, P.in[I_PSCALE] + l * 256);
        }
        SEAM(base + 2);
        if (IN(base + 3)) { FRESH();
            pg8::Gemm g{HB, (const bf16_t*)(F.ws + WS_WOUT) + (size_t)l * ND * ND, ND};
            pg8::StaticOrder S; S.init(NT, ND, F.G, (int)blockIdx.x);
            pg8::EpiResid E{(l == 0) ? P.in[I_X] : P.out, P.out, mod + (size_t)l * NB * NMOD + 2048};
            pg8::gemm_phase<pg8::EpiResid, pg8::StaticOrder, false, false>(F.lds, F.tid, g, S, E);
        }
        SEAM(base + 3);
        if (IN(base + 4)) { FRESH(); router_phase(F, l, P.out, mod + (size_t)l * NB * NMOD, HB); }
        SEAM(base + 4);
        if (IN(base + 5)) { FRESH();
            for (int first = 0;; first += 4) {
                const int nl = build_group_tables(F, l, 2, first, true);
                if (nl == 0) break;
                pg8::GroupedOrder S{(const LAS int*)(F.lds + TAB_OFF), (const LAS unsigned*)(F.lds + TAB_ROWS_OFF), nl};
                pg8::Gemm g{HB, (const bf16_t*)(F.ws + WS_WUP) + (size_t)l * NEXP * 512 * ND, ND};
                pg8::EpiSwiGLU E{(bf16_t*)(F.ws + WS_HID)};
                pg8::gemm_phase<pg8::EpiSwiGLU, pg8::GroupedOrder, false, true>(F.lds, F.tid, g, S, E);
                if (nl < 4) break;
            }
        }
        SEAM(base + 5);
        if (IN(base + 6)) { FRESH();
            for (int first = 0;; first += 4) {
                const int nl = build_group_tables(F, l, 4, first, false);
                if (nl == 0) break;
                pg8::GroupedOrder S{(const LAS int*)(F.lds + TAB_OFF), nullptr, nl};
                pg8::Gemm g{(const bf16_t*)(F.ws + WS_HID), (const bf16_t*)(F.ws + WS_WDN) + (size_t)l * NEXP * ND * NF, NF};
                pg8::EpiScatter E{YM, (const LAS int*)(F.lds + TAB_ROWS_OFF), (const LAS float*)(F.lds + TAB_ROWS2_OFF)};
                pg8::gemm_phase<pg8::EpiScatter, pg8::GroupedOrder, false, false>(F.lds, F.tid, g, S, E);
                if (nl < 4) break;
            }
        }
        SEAM(base + 6);
    }
    if (IN(PH_FINAL)) { FRESH(); ln_rows<1, 0>(F, P.out, P.out, YM, mod + (size_t)(NL - 1) * NB * NMOD + 5120, nullptr, nullptr, 0, 0, nullptr); }
#undef IN
#undef SEAM
}

static void launch_phases(const Params& base, int lo, int hi, int grid, hipStream_t stream) {
    Params p = base; p.ph_lo = lo; p.ph_hi = hi;
    hipLaunchKernelGGL(fwd_kernel, dim3(grid), dim3(NWAVES * 64), LDS_BYTES, stream, p);
}

extern "C" void kernel_launch(void* const* d_in, const int* in_sizes, int n_in, void* d_out, int out_size, void* d_ws, size_t ws_size, hipStream_t stream) {
    static int grid = 0;
    if (grid == 0) {
        int dev = 0, cus = 0;
        hipGetDevice(&dev);
        hipDeviceGetAttribute(&cus, hipDeviceAttributeMultiprocessorCount, dev);
        hipFuncSetAttribute((const void*)fwd_kernel, hipFuncAttributeMaxDynamicSharedMemorySize, LDS_BYTES);
        (void)hipGetLastError();
        grid = cus > 0 ? cus : 256;
    }
    hipMemsetAsync((char*)d_ws + WS_CTL, 0, CTL_ZERO_BYTES, stream);
    Params P{};
    for (int i = 0; i < 24; ++i) P.in[i] = (const float*)d_in[i];
    P.out = (float*)d_out; P.ws = (unsigned char*)d_ws;

#ifdef MULTI_LAUNCH
    for (int ph = 0; ph < PH_END; ++ph) launch_phases(P, ph, ph + 1, grid, stream);
#else
    launch_phases(P, 0, PH_END, grid, stream);
#endif
}
```

```cpp
#include <hip/hip_runtime.h>
#include <math.h>
#include <stdint.h>

constexpr int NB = 8, NS = 2048, ND = 1024, NT = NB * NS, NL = 2;
constexpr int INW = 2560, NMOD = 6144, NEXP = 32, NF = 256;
constexpr float EPS = 1e-6f;
constexpr float QSCALE = 0.125f * 1.4426950408889634f;

#define LAS __attribute__((address_space(3)))
#define GAS __attribute__((address_space(1)))
typedef unsigned short bf16_t;
typedef short bf16x8 __attribute__((ext_vector_type(8)));
typedef float f32x4 __attribute__((ext_vector_type(4)));
typedef float f32x16 __attribute__((ext_vector_type(16)));
typedef unsigned u32x4 __attribute__((ext_vector_type(4)));
typedef unsigned u32x2 __attribute__((ext_vector_type(2)));

__device__ const double ROPE_REV[32] = {
1.59154943091895345608e-01, 1.19349370211248861917e-01, 8.94994016088910132600e-02, 6.71150830052272551196e-02,
5.03292121044870352509e-02, 3.77415847174197710556e-02, 2.83021958306233986646e-02, 2.12236527647776604399e-02,
1.59154943091895338669e-02, 1.19349370211248861917e-02, 8.94994016088910236684e-03, 6.71150830052272533849e-03,
5.03292121044870369856e-03, 3.77415847174197719230e-03, 2.83021958306233986646e-03, 2.12236527647776621747e-03,
1.59154943091895334333e-03, 1.19349370211248848907e-03, 8.94994016088910128263e-04, 6.71150830052272490481e-04,
5.03292121044870326488e-04, 3.77415847174197686704e-04, 2.83021958306233954120e-04, 2.12236527647776605484e-04,
1.59154943091895323490e-04, 1.19349370211248848907e-04, 8.94994016088910182474e-05, 6.71150830052272544691e-05,
5.03292121044870353593e-05, 3.77415847174197700256e-05, 2.83021958306233960897e-05, 2.12236527647776591931e-05};

__device__ __forceinline__ float bf2f(bf16_t v) { return __uint_as_float(((unsigned)v) << 16); }
__device__ __forceinline__ unsigned f2bf_u(float f) { unsigned u = __float_as_uint(f); return (u + 0x7fffu + ((u >> 16) & 1u)) >> 16; }
__device__ __forceinline__ bf16_t f2bf(float f) { return (bf16_t)f2bf_u(f); }
__device__ __forceinline__ unsigned pk2(float lo, float hi) { return f2bf_u(lo) | (f2bf_u(hi) << 16); }
template <int CTRL> __device__ __forceinline__ float dpp_f(float v) { return __int_as_float(__builtin_amdgcn_update_dpp(0, __float_as_int(v), CTRL, 0xf, 0xf, true)); }
__device__ __forceinline__ float xor16_f(float v) { return __int_as_float(__builtin_amdgcn_ds_swizzle(__float_as_int(v), 0x401F)); }
__device__ __forceinline__ float xor32_sum(float v) { auto r = __builtin_amdgcn_permlane32_swap(__float_as_uint(v), __float_as_uint(v), false, false); return __uint_as_float(r[0]) + __uint_as_float(r[1]); }
__device__ __forceinline__ float sum_fq(float v) { v += xor16_f(v); return xor32_sum(v); }
__device__ __forceinline__ float wave_sum(float v) {
    v += dpp_f<0xB1>(v); v += dpp_f<0x4E>(v); v += dpp_f<0x141>(v); v += dpp_f<0x140>(v); v += xor16_f(v);
    return xor32_sum(v);
}
__device__ __forceinline__ float wave_max(float v) {
    v = fmaxf(v, dpp_f<0xB1>(v)); v = fmaxf(v, dpp_f<0x4E>(v)); v = fmaxf(v, dpp_f<0x141>(v)); v = fmaxf(v, dpp_f<0x140>(v)); v = fmaxf(v, xor16_f(v));
    auto r = __builtin_amdgcn_permlane32_swap(__float_as_uint(v), __float_as_uint(v), false, false); return fmaxf(__uint_as_float(r[0]), __uint_as_float(r[1]));
}

constexpr size_t MiB = 1u << 20;
constexpr size_t WS_CTL = 0, CTL_ZERO_BYTES = 1 * MiB;
constexpr size_t WS_MOD = 1 * MiB;
constexpr size_t WS_COS = 1 * MiB + 512 * 1024, WS_SIN = 1 * MiB + 768 * 1024;
constexpr size_t WS_LAM = 2 * MiB;
constexpr size_t WS_GAINS = 2 * MiB + 4096;
constexpr size_t WS_SELW = 2 * MiB + 64 * 1024;
constexpr size_t WS_WRT = 2 * MiB + 512 * 1024;
constexpr size_t WS_PERM = 3 * MiB;
constexpr size_t WS_WIN = 6 * MiB;
constexpr size_t WS_WOUT = 16 * MiB;
constexpr size_t WS_WUP = 20 * MiB;
constexpr size_t WS_WDN = 84 * MiB;
constexpr size_t WS_HB = 116 * MiB;
constexpr size_t WS_ZB = 148 * MiB;
constexpr size_t WS_HID = 228 * MiB;
constexpr size_t WS_END = 248 * MiB;
constexpr int CW_BAR = 4096;
constexpr int CW_CNT = 8192;

namespace pg8 {
constexpr int BM = 256, BK = 64, HALF = 128, HTB = HALF * BK * 2  , STAGE_BYTES = 8 * HTB, NXCD = 8, WGM = 8;

__host__ __device__ __forceinline__ int lds_byte(int r, int c) { const int st = (r >> 4) * 2 + (c >> 5), rr = r & 15, cc = c & 31, ob = rr * 64 + cc * 2; return st * 1024 + (ob ^ (((ob >> 9) & 1) << 5)); }
__host__ __device__ __forceinline__ void stage_rc(int b, int& R, int& C) { const int st = b / 1024, sb = b % 1024, swz = sb ^ (((sb >> 9) & 1) << 5); R = (st >> 1) * 16 + swz / 64; C = (st & 1) * 32 + (swz % 64) / 2; }
__host__ __device__ __forceinline__ int perm32(int rho) { const int n = rho >> 4, i = rho & 15; return 8 * (i >> 2) + 4 * n + (i & 3); }

struct Unit { int pm, pn, aux; };
struct Gemm { const bf16_t* A; const bf16_t* Bt; int K; };

struct StaticOrder {
    int nM, nN, nwg, G, c;
    __device__ void init(int M, int N, int G_, int c_) { nM = M / BM; nN = N / BM; nwg = nM * nN; G = G_; c = c_; }
    __device__ bool next(int i, Unit& u) const {
        const long L = (long)i * G + c; if (L >= nwg) return false;
        int wgid = (int)L; { const int q = nwg / NXCD, r = nwg % NXCD, xcd = wgid % NXCD, off = wgid / NXCD; wgid = (xcd < r ? xcd * (q + 1) : r * (q + 1) + (xcd - r) * q) + off; }
        const int nig = WGM * nN, gid = wgid / nig, fm = gid * WGM, gsz = (nM - fm) < WGM ? (nM - fm) : WGM;
        u.pm = fm + ((wgid % nig) % gsz); u.pn = (wgid % nig) / gsz; u.aux = 0; return true;
    }
    __device__ __forceinline__ unsigned a_off(int, int) const { return 0u; }
};
struct GroupedOrder {
    const LAS int* tab;
    const LAS unsigned* rowoff;
    int n_local;
    __device__ __forceinline__ bool next(int i, Unit& u) const { if (i >= n_local) return false; u.pm = tab[i * 4]; u.pn = tab[i * 4 + 1]; u.aux = i; return true; }
    __device__ __forceinline__ unsigned a_off(int i, int rr) const { return rowoff[i * 256 + rr]; }
};

template <class Epi, class Sched, bool ALIGN_EPI, bool GATHER>
__device__ __forceinline__ void gemm_phase(LAS unsigned char* lds, const int tid, const Gemm g, const Sched& S, const Epi& E) {
    const int wid = __builtin_amdgcn_readfirstlane(tid >> 6), lane = tid & 63, wr = wid >> 2, wc = wid & 3, fr = lane & 15, fq = lane >> 4;
    const int K = g.K, nt = K / BK;
    unsigned voffA[2], voffB[2]; int Rrow[2];
#pragma unroll
    for (int i = 0; i < 2; ++i) { int R, C; stage_rc(tid * 16 + i * 8192, R, C); const int Rb = Epi::PERM ? ((R & ~31) + perm32(R & 31)) : R;
        voffA[i] = GATHER ? (unsigned)(C * 2) : (unsigned)(R * K + C) * 2u; voffB[i] = (unsigned)(Rb * K + C) * 2u; Rrow[i] = R; }
    const size_t kstep = (size_t)(BK * 2);
    const size_t hstep = (size_t)HALF * K * 2;
    const size_t hstepA = GATHER ? 0 : hstep;
    const size_t tstep = 2 * hstep;
    const unsigned ldsw = (unsigned)wid * 1024u;
    const int aoff = lds_byte(wr * 64 + fr, fq * 8), boff = lds_byte(wc * 32 + fr, fq * 8);
#define PG8_SA(b, h) (((b) * 2 + (h)) * HTB)
#define PG8_SB(b, h) ((4 + (b) * 2 + (h)) * HTB)
#define PG8_STAGE(bufoff, gbase, voff) do { _Pragma("unroll") for (int _i = 0; _i < 2; ++_i) \
        __builtin_amdgcn_global_load_lds((const unsigned*)((const char*)(gbase) + (voff)[_i]), (LAS unsigned*)(lds + (bufoff) + ldsw + _i * 8192), 16, 0, 0); } while (0)
#define PG8_LDA(dst, b, h) do { _Pragma("unroll") for (int m = 0; m < 4; ++m) _Pragma("unroll") for (int k = 0; k < 2; ++k) dst[m][k] = *(const LAS bf16x8*)(lds + PG8_SA(b, h) + aoff + m * 2048 + k * 1024); } while (0)
#define PG8_LDB(dst, b, h) do { _Pragma("unroll") for (int n = 0; n < 2; ++n) _Pragma("unroll") for (int k = 0; k < 2; ++k) dst[n][k] = *(const LAS bf16x8*)(lds + PG8_SB(b, h) + boff + n * 2048 + k * 1024); } while (0)
#define PG8_MMA(ai, bj, At, Bt) do { __builtin_amdgcn_s_setprio(1); _Pragma("unroll") for (int m = 0; m < 4; ++m) _Pragma("unroll") for (int n = 0; n < 2; ++n) _Pragma("unroll") for (int k = 0; k < 2; ++k) \
        acc[ai][bj][m][n] = __builtin_amdgcn_mfma_f32_16x16x32_bf16(Bt[n][k], At[m][k], acc[ai][bj][m][n], 0, 0, 0); __builtin_amdgcn_s_setprio(0); } while (0)
#define PG8_WAIT_V(n) asm volatile("s_waitcnt vmcnt(" #n ")" ::: "memory")
#define PG8_WAIT_L(n) asm volatile("s_waitcnt lgkmcnt(" #n ")" ::: "memory")
#define PG8_BAR __builtin_amdgcn_s_barrier()
#define PG8_SCHED __builtin_amdgcn_sched_barrier(0)
    Unit cur, nxt; int ui = 0;
    if (!S.next(0, cur)) return;
    f32x4 acc[2][2][4][2];
#pragma unroll
    for (int a = 0; a < 2; ++a)
#pragma unroll
        for (int b = 0; b < 2; ++b)
#pragma unroll
            for (int m = 0; m < 4; ++m)
#pragma unroll
                for (int n = 0; n < 2; ++n) acc[a][b][m][n] = (f32x4){0.f, 0.f, 0.f, 0.f};
    bf16x8 At[4][2], B0[2][2], B1[2][2];
    unsigned vAc0[2], vAc1[2], vAn0[2], vAn1[2];
#pragma unroll
    for (int i = 0; i < 2; ++i) {
        if (GATHER) { vAc0[i] = S.a_off(cur.aux, Rrow[i]) + voffA[i]; vAc1[i] = S.a_off(cur.aux, HALF + Rrow[i]) + voffA[i]; }
        else { vAc0[i] = voffA[i]; vAc1[i] = voffA[i]; }
        vAn0[i] = vAc0[i]; vAn1[i] = vAc1[i];
    }
    const char* cA = (const char*)g.A + (GATHER ? (size_t)0 : (size_t)cur.pm * tstep); const char* cB = (const char*)g.Bt + (size_t)cur.pn * tstep;
    PG8_STAGE(PG8_SB(0, 0), cB, voffB); PG8_STAGE(PG8_SB(0, 1), cB + hstep, voffB); PG8_STAGE(PG8_SA(0, 0), cA, vAc0); PG8_STAGE(PG8_SA(0, 1), cA + hstepA, vAc1);
    if (wr == 1) PG8_BAR;
    PG8_WAIT_V(2); PG8_BAR;
    PG8_STAGE(PG8_SB(1, 0), cB + kstep, voffB); PG8_STAGE(PG8_SA(1, 0), cA + kstep, vAc0); PG8_STAGE(PG8_SB(1, 1), cB + hstep + kstep, voffB);
    PG8_WAIT_V(6); PG8_BAR;
    for (;;) {
        const bool has_next = S.next(ui + 1, nxt);
        const char* nA = has_next ? (const char*)g.A + (GATHER ? (size_t)0 : (size_t)nxt.pm * tstep) : cA; const char* nB = has_next ? (const char*)g.Bt + (size_t)nxt.pn * tstep : cB;
        if (GATHER) {
#pragma unroll
            for (int i = 0; i < 2; ++i) {
                if (has_next) { vAn0[i] = S.a_off(nxt.aux, Rrow[i]) + voffA[i]; vAn1[i] = S.a_off(nxt.aux, HALF + Rrow[i]) + voffA[i]; }
                else { vAn0[i] = vAc0[i]; vAn1[i] = vAc1[i]; }
            }
        }
#pragma unroll 1
        for (int t = 0; t < nt; t += 2) {
            const bool last = (t == nt - 2);
            const char* a1 = cA + (size_t)(t + 1) * kstep;
            const char* a2 = last ? nA : cA + (size_t)(t + 2) * kstep; const char* b2 = last ? nB : cB + (size_t)(t + 2) * kstep;
            const char* a3 = a2 + kstep; const char* b3 = b2 + kstep;
            unsigned vs0[2], vs1[2];
#pragma unroll
            for (int i = 0; i < 2; ++i) { vs0[i] = (GATHER && last) ? vAn0[i] : vAc0[i]; vs1[i] = (GATHER && last) ? vAn1[i] : vAc1[i]; }
            PG8_LDB(B0, 0, 0); PG8_LDB(B1, 0, 1); PG8_SCHED; PG8_LDA(At, 0, 0); PG8_STAGE(PG8_SA(1, 1), a1 + hstepA, vAc1);
            PG8_WAIT_V(8); PG8_WAIT_L(0); PG8_BAR; PG8_MMA(0, 0, At, B0); PG8_MMA(0, 1, At, B1); PG8_BAR; PG8_SCHED;
            PG8_LDA(At, 0, 1); PG8_STAGE(PG8_SB(0, 0), b2, voffB); PG8_STAGE(PG8_SB(0, 1), b2 + hstep, voffB); PG8_STAGE(PG8_SA(0, 0), a2, vs0);
            PG8_WAIT_V(8); PG8_WAIT_L(0); PG8_BAR; PG8_MMA(1, 0, At, B0); PG8_MMA(1, 1, At, B1); PG8_BAR; PG8_SCHED;
            PG8_LDB(B0, 1, 0); PG8_LDB(B1, 1, 1); PG8_SCHED; PG8_LDA(At, 1, 0); PG8_STAGE(PG8_SA(0, 1), a2 + hstepA, vs1);
            PG8_WAIT_V(8); PG8_WAIT_L(0); PG8_BAR; PG8_MMA(0, 0, At, B0); PG8_MMA(0, 1, At, B1); PG8_BAR; PG8_SCHED;
            PG8_LDA(At, 1, 1); PG8_STAGE(PG8_SB(1, 0), b3, voffB); PG8_STAGE(PG8_SB(1, 1), b3 + hstep, voffB); PG8_STAGE(PG8_SA(1, 0), a3, vs0);
            PG8_WAIT_V(8); PG8_WAIT_L(0); PG8_BAR; PG8_MMA(1, 0, At, B0); PG8_MMA(1, 1, At, B1); PG8_BAR; PG8_SCHED;
        }
        if constexpr (ALIGN_EPI) { if (wr == 0) PG8_BAR; }
        E(acc, cur, wr, wc, fr, fq);
        if (!has_next) break;
#pragma unroll
        for (int a = 0; a < 2; ++a)
#pragma unroll
            for (int b = 0; b < 2; ++b)
#pragma unroll
                for (int m = 0; m < 4; ++m)
#pragma unroll
                    for (int n = 0; n < 2; ++n) acc[a][b][m][n] = (f32x4){0.f, 0.f, 0.f, 0.f};
        cur = nxt; cA = nA; cB = nB; ++ui;
#pragma unroll
        for (int i = 0; i < 2; ++i) { vAc0[i] = vAn0[i]; vAc1[i] = vAn1[i]; }
        if constexpr (ALIGN_EPI) { if (wr == 1) PG8_BAR; }
    }
    PG8_WAIT_V(0);
    if constexpr (!ALIGN_EPI) { if (wr == 0) PG8_BAR; }
    PG8_BAR;
#undef PG8_SA
#undef PG8_SB
#undef PG8_STAGE
#undef PG8_LDA
#undef PG8_LDB
#undef PG8_MMA
#undef PG8_WAIT_V
#undef PG8_WAIT_L
#undef PG8_BAR
#undef PG8_SCHED
}

__device__ __forceinline__ unsigned cvt_pk_bf16(float lo, float hi) { unsigned r; asm volatile("v_cvt_pk_bf16_f32 %0, %1, %2" : "=v"(r) : "v"(lo), "v"(hi)); return r; }

struct EpiInProj {
    static constexpr bool PERM = true;
    bf16_t* Z; const float *gains  , *cosT, *sinT;
    __device__ __forceinline__ void operator()(const f32x4 (&acc)[2][2][4][2], const Unit& u, int wr, int wc, int fr, int fq) const {
        const int pn = u.pn;
        const int row0 = u.pm * BM + wr * 64 + fr;
        const int colbase = pn * 256 + wc * 64 + 8 * fq;
        const bool normed = (pn < 4) || (pn == 7) || (pn == 8);
        if (normed) {
            const int gi = (pn < 2) ? 0 : (pn < 4) ? 1 : (pn == 7) ? 2 : 3;
            const float* gain = gains + gi * 64;
            const float qs = (pn < 2 || pn == 7) ? QSCALE : 1.0f;
            f32x4 g[2][2];
#pragma unroll
            for (int bj = 0; bj < 2; ++bj)
#pragma unroll
                for (int n = 0; n < 2; ++n) g[bj][n] = *(const f32x4*)(gain + 32 * bj + 8 * fq + 4 * n) * qs;
#pragma unroll
            for (int ai = 0; ai < 2; ++ai)
#pragma unroll
                for (int m = 0; m < 4; ++m) {
                    const int row = row0 + ai * HALF + m * 16, pos = row & (NS - 1);
                    float ss = 0.f;
#pragma unroll
                    for (int bj = 0; bj < 2; ++bj)
#pragma unroll
                        for (int n = 0; n < 2; ++n) { const f32x4 v = acc[ai][bj][m][n]; ss += (v[0] * v[0] + v[1] * v[1]) + (v[2] * v[2] + v[3] * v[3]); }
                    ss = sum_fq(ss);
                    const float rstd = 1.0f / sqrtf(ss * (1.f / 64.f) + EPS);
                    u32x4 wlo, whi;
#pragma unroll
                    for (int n = 0; n < 2; ++n) {
                        const f32x4 c = *(const f32x4*)(cosT + pos * 32 + 8 * fq + 4 * n), s = *(const f32x4*)(sinT + pos * 32 + 8 * fq + 4 * n);
                        const f32x4 lo = acc[ai][0][m][n] * rstd * g[0][n], hi = acc[ai][1][m][n] * rstd * g[1][n];
                        const f32x4 olo = lo * c - hi * s, ohi = hi * c + lo * s;
                        wlo[2 * n] = cvt_pk_bf16(olo[0], olo[1]); wlo[2 * n + 1] = cvt_pk_bf16(olo[2], olo[3]);
                        whi[2 * n] = cvt_pk_bf16(ohi[0], ohi[1]); whi[2 * n + 1] = cvt_pk_bf16(ohi[2], ohi[3]);
                    }
                    bf16_t* rowp = Z + (size_t)row * INW + colbase;
                    *(u32x4*)(rowp) = wlo; *(u32x4*)(rowp + 32) = whi;
                    asm volatile("" ::: "memory");
                }
        } else {
#pragma unroll
            for (int ai = 0; ai < 2; ++ai)
#pragma unroll
                for (int m = 0; m < 4; ++m) {
                    bf16_t* rowp = Z + (size_t)(row0 + ai * HALF + m * 16) * INW + colbase;
#pragma unroll
                    for (int bj = 0; bj < 2; ++bj) { const f32x4 v0 = acc[ai][bj][m][0], v1 = acc[ai][bj][m][1];
                        u32x4 w; w.x = cvt_pk_bf16(v0[0], v0[1]); w.y = cvt_pk_bf16(v0[2], v0[3]); w.z = cvt_pk_bf16(v1[0], v1[1]); w.w = cvt_pk_bf16(v1[2], v1[3]);
                        *(u32x4*)(rowp + 32 * bj) = w; }
                }
        }
    }
};
struct EpiResid {
    static constexpr bool PERM = false;
    const float* resid; float* out; const float* ga;
    __device__ __forceinline__ void operator()(const f32x4 (&acc)[2][2][4][2], const Unit& u, int wr, int wc, int fr, int fq) const {
        const int row0 = u.pm * BM + wr * 64 + fr, col0 = u.pn * BM + wc * 32 + 4 * fq;
        const int b = (u.pm * BM) / NS;
        f32x4 gv[2][2];
#pragma unroll
        for (int bj = 0; bj < 2; ++bj)
#pragma unroll
            for (int n = 0; n < 2; ++n) gv[bj][n] = *(const f32x4*)(ga + (size_t)b * NMOD + col0 + bj * HALF + n * 16);
#pragma unroll
        for (int ai = 0; ai < 2; ++ai)
#pragma unroll
            for (int m = 0; m < 4; ++m) { const size_t off = (size_t)(row0 + ai * HALF + m * 16) * ND + col0;
#pragma unroll
                for (int bj = 0; bj < 2; ++bj)
#pragma unroll
                    for (int n = 0; n < 2; ++n) { const f32x4 r = *(const f32x4*)(resid + off + bj * HALF + n * 16); *(f32x4*)(out + off + bj * HALF + n * 16) = r + gv[bj][n] * acc[ai][bj][m][n]; } }
    }
};
struct EpiSwiGLU {
    static constexpr bool PERM = true;
    bf16_t* hid;
    __device__ __forceinline__ void operator()(const f32x4 (&acc)[2][2][4][2], const Unit& u, int wr, int wc, int fr, int fq) const {
        const int row0 = u.pm * BM + wr * 64 + fr, f0 = (u.pn & 1) * 128 + wc * 16 + 4 * fq;
#pragma unroll
        for (int ai = 0; ai < 2; ++ai)
#pragma unroll
            for (int m = 0; m < 4; ++m) { bf16_t* rowp = hid + (size_t)(row0 + ai * HALF + m * 16) * NF + f0;
#pragma unroll
                for (int bj = 0; bj < 2; ++bj) { const f32x4 a = acc[ai][bj][m][0], c = acc[ai][bj][m][1]; f32x4 h;
#pragma unroll
                    for (int j = 0; j < 4; ++j) h[j] = a[j] * __builtin_amdgcn_rcpf(1.0f + __expf(-a[j])) * c[j];
                    u32x2 w; w.x = cvt_pk_bf16(h[0], h[1]); w.y = cvt_pk_bf16(h[2], h[3]);
                    *(u32x2*)(rowp + 64 * bj) = w; }
            }
    }
};
struct EpiScatter {
    static constexpr bool PERM = true;
    bf16_t* ym;
    const LAS int* rdest; const LAS float* rcw;
    __device__ __forceinline__ void operator()(const f32x4 (&acc)[2][2][4][2], const Unit& u, int wr, int wc, int fr, int fq) const {
        const int col0 = (u.pn & 3) * 256 + wc * 32 + 8 * fq;
#pragma unroll
        for (int ai = 0; ai < 2; ++ai)
#pragma unroll
            for (int m = 0; m < 4; ++m) {
                const int r = ai * HALF + wr * 64 + m * 16 + fr;
                const int dest = rdest[u.aux * 256 + r]; const float cw = rcw[u.aux * 256 + r];
                if (dest >= 0) {
                    bf16_t* rowp = ym + (size_t)dest * ND + col0;
#pragma unroll
                    for (int bj = 0; bj < 2; ++bj) {
                        const f32x4 v0 = acc[ai][bj][m][0] * cw, v1 = acc[ai][bj][m][1] * cw;
                        u32x4 w; w.x = cvt_pk_bf16(v0[0], v0[1]); w.y = cvt_pk_bf16(v0[2], v0[3]); w.z = cvt_pk_bf16(v1[0], v1[1]); w.w = cvt_pk_bf16(v1[2], v1[3]);
                        *(u32x4*)(rowp + bj * HALF) = w; }
                }
                asm volatile("" ::: "memory");
            }
    }
};
}

constexpr int NWAVES = 8;
constexpr int RING_BYTES = 131072;
constexpr int TAB_OFF = RING_BYTES;
constexpr int TAB_BYTES = 14336;
constexpr int MISC_OFF = TAB_OFF + TAB_BYTES;
constexpr int LDS_BYTES = 147456;
static_assert(MISC_OFF + 256 <= LDS_BYTES, "LDS map");

typedef GAS unsigned gu32;
#define RLX_AGENT __ATOMIC_RELAXED, __HIP_MEMORY_SCOPE_AGENT
#define LDS_WAIT() asm volatile("s_waitcnt lgkmcnt(0)" ::: "memory")
#define VM_WAIT() asm volatile("s_waitcnt vmcnt(0)" ::: "memory")

#define XB_TMO      128
#define XB_XCNT(j)  (256  + 64 * (j))
#define XB_XSUB(j)  (1280 + 64 * (j))
#define XB_XGEN(j)  (2304 + 64 * (j))
#define XB_TOP      3328
#define XB_TOPGEN   3392
#define XCD_BAR_WORDS 3456
#define XB_SPIN_CAP (1u << 18)
__device__ __forceinline__ unsigned xb_ld(unsigned* p)              { return __hip_atomic_load(p, __ATOMIC_RELAXED, __HIP_MEMORY_SCOPE_AGENT); }
__device__ __forceinline__ unsigned xb_add(unsigned* p, unsigned v) { return __hip_atomic_fetch_add(p, v, __ATOMIC_RELAXED, __HIP_MEMORY_SCOPE_AGENT); }
__device__ __forceinline__ unsigned xb_xcc_id() { return (unsigned)__builtin_amdgcn_s_getreg((3 << 11) | 20) & 0xFu; }
#define XB_SPIN(cond, bar) do { unsigned _sp = 0; while (cond) { __builtin_amdgcn_s_sleep(1); \
    if ((++_sp & 255u) == 0u) { if (xb_ld(&(bar)[XB_TMO])) break; if (_sp > XB_SPIN_CAP) { atomicAdd(&(bar)[XB_TMO], 1u); break; } } } } while (0)
struct XcdBarrier { unsigned* bar; unsigned x; volatile LAS unsigned* st; };
__device__ __forceinline__ XcdBarrier xcd_barrier_post(unsigned* bar, volatile LAS unsigned* st) {
    XcdBarrier b; b.bar = bar; b.x = xb_xcc_id(); b.st = st;
    if (threadIdx.x == 0) (void)xb_add(&bar[XB_XCNT(b.x)], 1u);
    return b;
}
__device__ __forceinline__ void xcd_barrier_complete(unsigned* bar, unsigned x, unsigned& nloc, unsigned& nx) {
    const unsigned G = gridDim.x * gridDim.y * gridDim.z;
    unsigned sum, cnt, mine, sp = 0u;
    for (;;) {
        sum = 0u; cnt = 0u; mine = 0u;
#pragma unroll
        for (unsigned j = 0; j < 16; ++j) { const unsigned c = xb_ld(&bar[XB_XCNT(j)]); sum += c; cnt += (c > 0u) ? 1u : 0u; mine = (j == x) ? c : mine; }
        if (sum == G) break;
        __builtin_amdgcn_s_sleep(1);
        if ((++sp & 255u) == 0u) { if (xb_ld(&bar[XB_TMO])) break; if (sp > XB_SPIN_CAP) { atomicAdd(&bar[XB_TMO], 1u); break; } }
    }
    nloc = mine > 0u ? mine : 1u; nx = cnt > 0u ? cnt : 1u;
}
__device__ __forceinline__ void xcd_barrier(const XcdBarrier& b) {
    asm volatile("s_waitcnt vmcnt(0)" ::: "memory");
    __syncthreads();
    if (threadIdx.x == 0) {
        unsigned* bar = b.bar;
        __builtin_amdgcn_s_waitcnt(0);
        unsigned nloc = b.st[0], nx = b.st[1];
        if (nloc == 0u) { xcd_barrier_complete(bar, b.x, nloc, nx); b.st[0] = nloc; b.st[1] = nx; }
        const unsigned old = xb_add(&bar[XB_XSUB(b.x)], 1u);
        const unsigned gen = old / nloc;
        if (old + 1u == (gen + 1u) * nloc) {
            __builtin_amdgcn_fence(__ATOMIC_RELEASE, "agent");
            asm volatile("s_waitcnt vmcnt(0)" ::: "memory");
            const unsigned og = xb_add(&bar[XB_TOP], 1u);
            const unsigned tg = og / nx;
            if (og + 1u == (tg + 1u) * nx) xb_add(&bar[XB_TOPGEN], 1u);
            else XB_SPIN(xb_ld(&bar[XB_TOPGEN]) == tg, bar);
            __builtin_amdgcn_fence(__ATOMIC_ACQUIRE, "agent");
            xb_add(&bar[XB_XGEN(b.x)], 1u);
            asm volatile("s_waitcnt vmcnt(0)" ::: "memory");
        } else {
            XB_SPIN(xb_ld(&bar[XB_XGEN(b.x)]) == gen, bar);
            __builtin_amdgcn_fence(__ATOMIC_ACQUIRE, "agent");
            asm volatile("s_waitcnt vmcnt(0)" ::: "memory");
        }
    }
    __syncthreads();
}

struct Params { const float* in[24]; float* out; unsigned char* ws; int ph_lo, ph_hi; };
enum { I_X = 0, I_C, I_WMOD, I_BMOD, I_GN1, I_WIN, I_GQA, I_GKA, I_LAMA, I_GSUBA, I_WPOOL, I_BPOOL, I_PSCALE, I_GQC, I_GKC, I_WOUT, I_GN2, I_WRG, I_BRG, I_WRE, I_BRE, I_W1, I_W3, I_W2 };

struct Frame {
    LAS unsigned char* lds;
    int tid, lane, wave, vcu, G;
    const float* const* in; float* out; unsigned char* ws;
};

template <class RowMap>
__device__ __forceinline__ void p0_transpose_item(const float* W, int ldw, int K, bf16_t* WT, LAS float* scr, int k0, int n0, int lane, const RowMap& rm) {
#pragma unroll 8
    for (int i = 0; i < 32; ++i) { const int kk = 2 * i + (lane >> 5); scr[kk * 33 + (lane & 31)] = W[(size_t)(k0 + kk) * ldw + n0 + (lane & 31)]; }
    LDS_WAIT(); asm volatile("" ::: "memory");
    const int c = lane & 7;
#pragma unroll
    for (int j = 0; j < 4; ++j) { const int n = (lane >> 3) + 8 * j; const LAS float* s = scr + (8 * c) * 33 + n;
        u32x4 o; o.x = pk2(s[0 * 33], s[1 * 33]); o.y = pk2(s[2 * 33], s[3 * 33]); o.z = pk2(s[4 * 33], s[5 * 33]); o.w = pk2(s[6 * 33], s[7 * 33]);
        *(GAS u32x4*)(WT + (size_t)rm(n0 + n) * K + k0 + 8 * c) = o; }
    LDS_WAIT(); asm volatile("" ::: "memory");
}
struct MapIn  { __device__ __forceinline__ int operator()(int n) const { return (n & ~255) + ((n >> 5) & 1) * 128 + ((n >> 6) & 3) * 32 + (n & 31); } };
struct MapId  { __device__ __forceinline__ int operator()(int n) const { return n; } };
struct MapUp  { int which; __device__ __forceinline__ int operator()(int f) const { return (f >> 7) * 256 + ((f >> 6) & 1) * 128 + ((f >> 4) & 3) * 32 + ((f >> 2) & 3) * 8 + which * 4 + (f & 3); } };

__device__ __forceinline__ void p0_prologue(Frame& F) {
    LAS float* scr = (LAS float*)(F.lds + F.wave * 8704);
    const int gw = F.vcu * NWAVES + F.wave, NGW = F.G * NWAVES;
    {
        LAS float* cond = (LAS float*)(F.lds + 98304);
        for (int i = F.tid; i < NB * ND; i += NWAVES * 64) { const float v = F.in[I_C][i]; cond[i] = v / (1.f + __expf(-v)); }
        __syncthreads();
        const int gwm = F.wave * F.G + F.vcu;
        for (int it = gwm; it < NL * (NMOD / 32); it += NGW) {
            const int l = it / (NMOD / 32), j = (it % (NMOD / 32)) * 32 + (F.lane & 31), kh = F.lane >> 5;
            const float* w = F.in[I_WMOD] + (size_t)l * ND * NMOD + (size_t)kh * 512 * NMOD + j;
            const LAS float* cd = cond + kh * 512;
            float acc[NB];
#pragma unroll
            for (int b = 0; b < NB; ++b) acc[b] = 0.f;
            for (int d0 = 0; d0 < 512; d0 += 32) {
                float wv[32];
#pragma unroll
                for (int q = 0; q < 32; ++q) wv[q] = w[(size_t)(d0 + q) * NMOD];
#pragma unroll
                for (int q = 0; q < 32; ++q)
#pragma unroll
                    for (int b = 0; b < NB; ++b) acc[b] += cd[b * ND + d0 + q] * wv[q];
            }
            float* mod = (float*)(F.ws + WS_MOD);
#pragma unroll
            for (int b = 0; b < NB; ++b) { const float tot = xor32_sum(acc[b]); if (kh == 0) mod[(size_t)(l * NB + b) * NMOD + j] = tot + F.in[I_BMOD][l * NMOD + j]; }
        }
    }
    {
        float* cosT = (float*)(F.ws + WS_COS); float* sinT = (float*)(F.ws + WS_SIN);
        for (int idx = gw * 64 + F.lane; idx < NS * 32; idx += NGW * 64) {
            const int t = idx >> 5, i = idx & 31;
            double r = (double)t * ROPE_REV[i]; r = r - rint(r);
            const float rf = (float)r;
            cosT[idx] = __builtin_amdgcn_cosf(rf); sinT[idx] = __builtin_amdgcn_sinf(rf);
        }
        if (gw == NGW - 2) {
            float* gains = (float*)(F.ws + WS_GAINS);
            for (int l = 0; l < NL; ++l) {
                gains[(l * 4 + 0) * 64 + F.lane] = F.in[I_GQA][l * 64 + F.lane]; gains[(l * 4 + 1) * 64 + F.lane] = F.in[I_GKA][l * 64 + F.lane];
                gains[(l * 4 + 2) * 64 + F.lane] = F.in[I_GQC][l * 64 + F.lane]; gains[(l * 4 + 3) * 64 + F.lane] = F.in[I_GKC][l * 64 + F.lane];
            }
        }
        if (gw == NGW - 3) {
            float* bnd = (float*)(F.ws + WS_LAM) + 16;
            for (int l = 0; l < NL; ++l) {
                const float qa = wave_max(fabsf(F.in[I_GQA][l * 64 + F.lane])), ka = wave_max(fabsf(F.in[I_GKA][l * 64 + F.lane]));
                const float qc = wave_max(fabsf(F.in[I_GQC][l * 64 + F.lane])), kc = wave_max(fabsf(F.in[I_GKC][l * 64 + F.lane]));
                if (F.lane == 0) { bnd[l * 2] = 64.f * QSCALE * qa * ka * 1.01f + 0.25f; bnd[l * 2 + 1] = 64.f * QSCALE * qc * kc * 1.01f + 0.25f; }
            }
        }
        {
            float* wrt = (float*)(F.ws + WS_WRT);
            for (int it = gw; it < NL * 36; it += NGW) {
                const int l = it / 36, n = it % 36;
                for (int d = F.lane; d < ND; d += 64)
                    wrt[(size_t)it * ND + d] = (n < 4) ? F.in[I_WRG][((size_t)l * ND + d) * 4 + n] : F.in[I_WRE][(((size_t)l * 4 + ((n - 4) >> 3)) * ND + d) * 8 + ((n - 4) & 7)];
            }
        }
        if (gw == NGW - 1) {
            float* lamv = (float*)(F.ws + WS_LAM);
            for (int l = 0; l < NL; ++l) {
                const float* lp = F.in[I_LAMA] + l * 256;
                const float a = wave_sum(lp[F.lane] * lp[64 + F.lane]);
                const float b = wave_sum(lp[128 + F.lane] * lp[192 + F.lane]);
                const float lam_init = 0.8f - 0.6f * expf(-0.3f * (float)l);
                if (F.lane == 0) { lamv[2 * l] = expf(a) - expf(b) + lam_init; lamv[2 * l + 1] = lam_init; }
            }
        }
    }
    {
        bf16_t* win = (bf16_t*)(F.ws + WS_WIN); bf16_t* wout = (bf16_t*)(F.ws + WS_WOUT); bf16_t* wup = (bf16_t*)(F.ws + WS_WUP); bf16_t* wdn = (bf16_t*)(F.ws + WS_WDN);
        constexpr int I_IN = NL * (ND / 64) * (INW / 32);
        constexpr int I_OUT = NL * (ND / 64) * (ND / 32);
        constexpr int I_UP = NL * NEXP * (ND / 64) * (NF / 32);
        constexpr int I_DN = NL * NEXP * (NF / 64) * (ND / 32);
        constexpr int NITEMS = I_IN + I_OUT + 2 * I_UP + I_DN;
        for (int it = gw; it < NITEMS; it += NGW) {
            int r = it;
            if (r < I_IN) { const int l = r / (I_IN / NL), q = r % (I_IN / NL), kb = q / (INW / 32), nb = q % (INW / 32);
                p0_transpose_item(F.in[I_WIN] + (size_t)l * ND * INW, INW, ND, win + (size_t)l * INW * ND, scr, kb * 64, nb * 32, F.lane, MapIn{}); continue; }
            r -= I_IN;
            if (r < I_OUT) { const int l = r / (I_OUT / NL), q = r % (I_OUT / NL), kb = q / (ND / 32), nb = q % (ND / 32);
                p0_transpose_item(F.in[I_WOUT] + (size_t)l * ND * ND, ND, ND, wout + (size_t)l * ND * ND, scr, kb * 64, nb * 32, F.lane, MapId{}); continue; }
            r -= I_OUT;
            if (r < 2 * I_UP) { const int which = r / I_UP, q0 = r % I_UP, le = q0 / ((ND / 64) * (NF / 32)), q = q0 % ((ND / 64) * (NF / 32)), kb = q / (NF / 32), nb = q % (NF / 32);
                p0_transpose_item(F.in[which ? I_W3 : I_W1] + (size_t)le * ND * NF, NF, ND, wup + (size_t)le * 512 * ND, scr, kb * 64, nb * 32, F.lane, MapUp{which}); continue; }
            r -= 2 * I_UP;
            { const int le = r / ((NF / 64) * (ND / 32)), q = r % ((NF / 64) * (ND / 32)), kb = q / (ND / 32), nb = q % (ND / 32);
                p0_transpose_item(F.in[I_W2] + (size_t)le * NF * ND, ND, NF, wdn + (size_t)le * ND * NF, scr, kb * 64, nb * 32, F.lane, MapId{}); }
        }
    }
}

template <int COMBINE, int WRITE_H>
__device__ __forceinline__ void ln_rows(Frame& F, const float* x, float* xw, const bf16_t* ym, const float* ga2  , const float* g, const float* modl, int sh_off, int sc_off, bf16_t* h) {
    const int gw = F.vcu * NWAVES + F.wave, NGW = F.G * NWAVES;
    for (int row = gw; row < NT; row += NGW) {
        const int b = row / NS;
        const f32x4* xr = (const f32x4*)(x + (size_t)row * ND) + F.lane;
        f32x4 v[4]; float ss = 0.f;
#pragma unroll
        for (int j = 0; j < 4; ++j) v[j] = xr[64 * j];
        if (COMBINE) {
            const u32x2* y0 = (const u32x2*)(ym + (size_t)row * 2048) + F.lane;
#pragma unroll
            for (int j = 0; j < 4; ++j) { const u32x2 a = y0[64 * j], c = y0[256 + 64 * j];
                const f32x4 gt = *(const f32x4*)(ga2 + (size_t)b * NMOD + (F.lane + 64 * j) * 4);
                v[j][0] += gt[0] * (__uint_as_float(a.x << 16) + __uint_as_float(c.x << 16)); v[j][1] += gt[1] * (__uint_as_float(a.x & 0xffff0000u) + __uint_as_float(c.x & 0xffff0000u));
                v[j][2] += gt[2] * (__uint_as_float(a.y << 16) + __uint_as_float(c.y << 16)); v[j][3] += gt[3] * (__uint_as_float(a.y & 0xffff0000u) + __uint_as_float(c.y & 0xffff0000u));
                ((f32x4*)(xw + (size_t)row * ND) + F.lane)[64 * j] = v[j]; }
        }
        if (WRITE_H) {
#pragma unroll
            for (int j = 0; j < 4; ++j) ss += (v[j][0] * v[j][0] + v[j][1] * v[j][1]) + (v[j][2] * v[j][2] + v[j][3] * v[j][3]);
            ss = wave_sum(ss);
            const float rstd = 1.0f / sqrtf(ss * (1.f / ND) + EPS);
            const float* mb = modl + (size_t)b * NMOD;
            u32x2* o8 = (u32x2*)(h + (size_t)row * ND) + F.lane;
#pragma unroll
            for (int j = 0; j < 4; ++j) {
                const int d = (F.lane + 64 * j) * 4;
                const f32x4 gg = *(const f32x4*)(g + d), sc = *(const f32x4*)(mb + sc_off + d), sh = *(const f32x4*)(mb + sh_off + d);
                const f32x4 o = v[j] * rstd * gg * (sc + 1.0f) + sh;
                u32x2 w; w.x = pk2(o[0], o[1]); w.y = pk2(o[2], o[3]); o8[64 * j] = w;
            }
        }
    }
}

__device__ __forceinline__ void router_phase(Frame& F, int l, int lc  , const float* x, const float* modl, bf16_t* h) {
    const int gw = F.vcu * NWAVES + F.wave, NGW = F.G * NWAVES;
    const float* g = F.in[I_GN2] + l * ND;
    const float* wrt = (const float*)(F.ws + WS_WRT) + (size_t)l * 36 * ND;
    const float* b_rg = F.in[I_BRG] + l * 4; const float* b_re = F.in[I_BRE] + l * 32;
    LAS int* lcnt = (LAS int*)(F.lds + TAB_OFF);
    LAS float* lg = (LAS float*)(F.lds + TAB_OFF + 512) + F.wave * 320;
    int* perm = (int*)(F.ws + WS_PERM); float* selw = (float*)(F.ws + WS_SELW);
    unsigned* cntw = (unsigned*)(F.ws + WS_CTL) + CW_CNT + (size_t)lc * 32 * 64;
#pragma unroll 1
    for (int chunk = 0; chunk * 8 * NGW < NT; ++chunk) {
        if (F.tid < 64) lcnt[F.tid] = 0;
        __syncthreads();
        f32x4 v[8][4];
#pragma unroll
        for (int r = 0; r < 8; ++r) {
            const int row = (chunk * 8 + r) * NGW + gw;
            const int b = row / NS;
            const f32x4* xr = (const f32x4*)(x + (size_t)row * ND) + F.lane;
            float ss = 0.f;
#pragma unroll
            for (int j = 0; j < 4; ++j) { v[r][j] = xr[64 * j]; ss += (v[r][j][0] * v[r][j][0] + v[r][j][1] * v[r][j][1]) + (v[r][j][2] * v[r][j][2] + v[r][j][3] * v[r][j][3]); }
            ss = wave_sum(ss);
            const float rstd = 1.0f / sqrtf(ss * (1.f / ND) + EPS);
            const float* mb = modl + (size_t)b * NMOD;
            u32x2* o8 = (u32x2*)(h + (size_t)row * ND) + F.lane;
#pragma unroll
            for (int j = 0; j < 4; ++j) {
                const int d = (F.lane + 64 * j) * 4;
                const f32x4 gg = *(const f32x4*)(g + d), sc = *(const f32x4*)(mb + 4096 + d), sh = *(const f32x4*)(mb + 3072 + d);
                v[r][j] = v[r][j] * rstd * gg * (sc + 1.0f) + sh;
                u32x2 w; w.x = pk2(v[r][j][0], v[r][j][1]); w.y = pk2(v[r][j][2], v[r][j][3]); o8[64 * j] = w;
            }
        }
#pragma unroll 2
        for (int n = 0; n < 36; ++n) {
            const f32x4* wp = (const f32x4*)(wrt + (size_t)n * ND) + F.lane;
            const f32x4 w0 = wp[0], w1 = wp[64], w2 = wp[128], w3 = wp[192];
#pragma unroll
            for (int r = 0; r < 8; ++r) {
                const f32x4 p = v[r][0] * w0 + v[r][1] * w1 + v[r][2] * w2 + v[r][3] * w3;
                const float s = wave_sum((p[0] + p[1]) + (p[2] + p[3]));
                if (F.lane == 0) lg[r * 40 + n] = s;
            }
        }
        asm volatile("s_waitcnt lgkmcnt(0)" ::: "memory");
        int e0 = -1, e1 = -1, row2 = 0, rk0 = 0, rk1 = 0; float w0s = 0.f, w1s = 0.f;
        if (F.lane < 8) {
            const int r = F.lane; const LAS float* q = lg + r * 40;
            float gl[4];
#pragma unroll
            for (int gi = 0; gi < 4; ++gi) gl[gi] = q[gi] + b_rg[gi];
            int gidx = 0; float gm = gl[0];
#pragma unroll
            for (int gi = 1; gi < 4; ++gi) if (gl[gi] > gm) { gm = gl[gi]; gidx = gi; }
            float gs = 0.f;
#pragma unroll
            for (int gi = 0; gi < 4; ++gi) gs += expf(gl[gi] - gm);
            const float g_w = 1.0f / gs;
            float el[8];
#pragma unroll
            for (int e = 0; e < 8; ++e) el[e] = q[4 + gidx * 8 + e] + b_re[gidx * 8 + e];
            int i0 = 0; float v0 = el[0];
#pragma unroll
            for (int e = 1; e < 8; ++e) if (el[e] > v0) { v0 = el[e]; i0 = e; }
            int i1 = -1; float v1 = -INFINITY;
#pragma unroll
            for (int e = 0; e < 8; ++e) if (e != i0 && el[e] > v1) { v1 = el[e]; i1 = e; }
            const float ex = expf(v1 - v0);
            w0s = g_w / (1.0f + ex); w1s = g_w * ex / (1.0f + ex);
            e0 = gidx * 8 + i0; e1 = gidx * 8 + i1; row2 = ((chunk * 8 + r) * NGW + gw) * 2;
            rk0 = __hip_atomic_fetch_add(lcnt + e0, 1, __ATOMIC_RELAXED, __HIP_MEMORY_SCOPE_WORKGROUP);
            rk1 = __hip_atomic_fetch_add(lcnt + e1, 1, __ATOMIC_RELAXED, __HIP_MEMORY_SCOPE_WORKGROUP);
        }
        __syncthreads();
        if (F.tid < 32) { const int c = lcnt[F.tid]; int basev = 0;
            if (c > 0) basev = (int)__hip_atomic_fetch_add(cntw + F.tid * 64, (unsigned)c, __ATOMIC_RELAXED, __HIP_MEMORY_SCOPE_AGENT);
            lcnt[32 + F.tid] = basev; }
        __syncthreads();
        if (e0 >= 0) {
            perm[e0 * 16384 + lcnt[32 + e0] + rk0] = row2;     selw[row2] = w0s;
            perm[e1 * 16384 + lcnt[32 + e1] + rk1] = row2 + 1; selw[row2 + 1] = w1s;
        }
        __syncthreads();
    }
}

constexpr int TAB_ROWS_OFF = TAB_OFF + 512, TAB_ROWS2_OFF = TAB_OFF + 512 + 4096;
__device__ __forceinline__ int build_group_tables(Frame& F, int l, int npn, int first, bool up) {
    LAS int* tab = (LAS int*)(F.lds + TAB_OFF);
    int tid = threadIdx.x; asm volatile("" : "+v"(tid));
    const unsigned* cntw = (const unsigned*)(F.ws + WS_CTL) + CW_CNT + (size_t)l * 32 * 64;
    __syncthreads();
    if (tid < 32) tab[16 + tid] = (int)__hip_atomic_load(cntw + tid * 64, __ATOMIC_RELAXED, __HIP_MEMORY_SCOPE_AGENT);
    __syncthreads();
    if (tid == 0) { int acc = 0; for (int e = 0; e < 32; ++e) { tab[48 + e] = acc; acc += (tab[16 + e] + 255) >> 8; } tab[80] = acc; }
    __syncthreads();
    const int U = tab[80] * npn;
    int n_local = 0;
    for (int i = 0; i < 4; ++i) {
        const int gi = F.vcu + (first + i) * F.G;
        if (gi >= U) break;
        n_local = i + 1;
        const int mtg = gi / npn, pn = gi % npn;
        int e = 0;
        for (int q = 1; q < 32; ++q) if (tab[48 + q] <= mtg) e = q;
        while (e > 0 && ((tab[16 + e] + 255) >> 8) == 0) --e;
        const int mt = mtg - tab[48 + e], cnt = tab[16 + e];
        if (tid == 0) { tab[i * 4] = mtg; tab[i * 4 + 1] = e * npn + pn; tab[i * 4 + 2] = min(256, cnt - mt * 256); tab[i * 4 + 3] = e; }
        if (tid < 256) {
            const int idx = mt * 256 + tid; const bool valid = idx < cnt;
            const int entry = valid ? ((const int*)(F.ws + WS_PERM))[e * 16384 + idx] : 0;
            if (up) ((LAS unsigned*)(F.lds + TAB_ROWS_OFF))[i * 256 + tid] = (unsigned)(entry >> 1) * (unsigned)(ND * 2);
            else { ((LAS int*)(F.lds + TAB_ROWS_OFF))[i * 256 + tid] = valid ? entry : -1; ((LAS float*)(F.lds + TAB_ROWS2_OFF))[i * 256 + tid] = valid ? ((const float*)(F.ws + WS_SELW))[entry] : 0.f; }
        }
    }
    __syncthreads();
    return n_local;
}

namespace mix {
typedef short s16x4 __attribute__((ext_vector_type(4)));
__device__ __forceinline__ int crow(int r, int hi) { return (r & 3) + 8 * (r >> 2) + 4 * hi; }
__device__ __forceinline__ s16x4 vtr(const LAS unsigned char* p) { return __builtin_bit_cast(s16x4, __builtin_amdgcn_ds_read_tr16_b64_v4i16((LAS s16x4*)p)); }
__device__ __forceinline__ unsigned cvtpk(float lo, float hi) { unsigned r; asm volatile("v_cvt_pk_bf16_f32 %0, %1, %2" : "=v"(r) : "v"(lo), "v"(hi)); return r; }
#define MIX_MFMA32(a, b, c) __builtin_amdgcn_mfma_f32_32x32x16_bf16((a), (b), (c), 0, 0, 0)

constexpr int DA_STAGE = 65536, DA_K1 = 16384, DA_V = 32768;
__device__ __forceinline__ void da_stage_load(LAS unsigned char* lds, int buf, const bf16_t* Zb, int h, int key0, int wave, int lane) {
#pragma unroll
    for (int i = 0; i < 8; ++i) {
        const int p = wave * 8 + i;
        const bf16_t* src; int dst;
        if (p < 32) { const int m = p >> 4, q = p & 15, row = 8 * q + (lane >> 3);
            src = Zb + (size_t)(key0 + row) * INW + 512 + h * 128 + m * 64 + (((lane & 7) ^ (row & 7)) * 8);
            dst = buf * DA_STAGE + m * DA_K1 + q * 1024; }
        else { const int q = p - 32, kp = q >> 4, dvb = (q >> 2) & 3, rg = q & 3;
            src = Zb + (size_t)(key0 + kp * 64 + rg * 16 + (lane >> 2)) * INW + 1024 + h * 128 + dvb * 32 + (lane & 3) * 8;
            dst = buf * DA_STAGE + DA_V + kp * 16384 + dvb * 4096 + rg * 1024; }
        __builtin_amdgcn_global_load_lds((const unsigned*)src, (LAS unsigned*)(lds + dst), 16, 0, 0);
    }
}

__device__ __forceinline__ void da_unit(Frame& F, int b, int h, int j, const bf16_t* Z, bf16_t* ycat, float lam, float omli, float negCb, const float* gsub) {
    LAS unsigned char* lds = F.lds;
    const int lane = F.lane, wave = F.wave, r32 = lane & 31, hi = lane >> 5, qsub = wave & 3, m = wave >> 2;
    const bf16_t* Zb = Z + (size_t)b * NS * INW;
    const int vrd = ((lane >> 4) & 1) * 32 + (lane & 3) * 8 + (4 * hi + ((lane & 15) >> 2)) * 64;
#pragma unroll 1
    for (int half = 0; half < 2; ++half) {
        const int qb = half ? (15 - j) : j, q0 = qb * 128, nsteps = qb + 1;
        da_stage_load(lds, 0, Zb, h, 0, wave, lane);
        bf16x8 qr[4];
        { const bf16_t* qp = Zb + (size_t)(q0 + qsub * 32 + r32) * INW + h * 128 + m * 64 + hi * 8;
#pragma unroll
          for (int d0 = 0; d0 < 4; ++d0) qr[d0] = *(const bf16x8*)(qp + d0 * 16); }
        f32x16 O[4];
#pragma unroll
        for (int d = 0; d < 4; ++d)
#pragma unroll
            for (int r = 0; r < 16; ++r) O[d][r] = 0.f;
        float lsum = 0.f;
#pragma unroll 1
        for (int s = 0; s < nsteps; ++s) {
            const int buf = s & 1;
            if (s + 1 < nsteps) { da_stage_load(lds, buf ^ 1, Zb, h, (s + 1) * 128, wave, lane); asm volatile("s_waitcnt vmcnt(8)" ::: "memory"); }
            else asm volatile("s_waitcnt vmcnt(0)" ::: "memory");
            __builtin_amdgcn_s_barrier(); asm volatile("" ::: "memory");
            const bool diag = (s == qb);
#pragma unroll 1
            for (int kp = 0; kp < 2; ++kp) {
                if (diag && kp == 1 && qsub < 2) break;
                const LAS unsigned char* kb = lds + buf * DA_STAGE + m * DA_K1 + (kp * 64 + r32) * 128;
                const LAS unsigned char* vb = lds + buf * DA_STAGE + DA_V + kp * 16384 + vrd;
                f32x16 s0, s1;
#pragma unroll
                for (int r = 0; r < 16; ++r) { s0[r] = negCb; s1[r] = negCb; }
#pragma unroll
                for (int d0 = 0; d0 < 4; ++d0) {
                    const int ko = ((2 * d0 + hi) ^ (r32 & 7)) * 16;
                    const bf16x8 k0 = *(const LAS bf16x8*)(kb + ko);
                    const bf16x8 k1 = *(const LAS bf16x8*)(kb + ko + 4096);
                    s0 = MIX_MFMA32(k0, qr[d0], s0); s1 = MIX_MFMA32(k1, qr[d0], s1);
                }
                if (diag) {
                    const int qrel = qsub * 32 + r32, kbase = kp * 64 + 4 * hi;
#pragma unroll
                    for (int r = 0; r < 16; ++r) { const int kv = kbase + (r & 3) + 8 * (r >> 2); if (kv > qrel) s0[r] = -INFINITY; if (kv + 32 > qrel) s1[r] = -INFINITY; }
                }
                float ls = 0.f;
#pragma unroll
                for (int r = 0; r < 16; ++r) { s0[r] = __builtin_amdgcn_exp2f(s0[r]); s1[r] = __builtin_amdgcn_exp2f(s1[r]); ls += s0[r] + s1[r]; }
                lsum += ls;
                bf16x8 pa[4];
                { u32x4 w0, w1, w2, w3;
                  w0 = (u32x4){cvtpk(s0[0], s0[1]), cvtpk(s0[2], s0[3]), cvtpk(s0[4], s0[5]), cvtpk(s0[6], s0[7])};
                  w1 = (u32x4){cvtpk(s0[8], s0[9]), cvtpk(s0[10], s0[11]), cvtpk(s0[12], s0[13]), cvtpk(s0[14], s0[15])};
                  w2 = (u32x4){cvtpk(s1[0], s1[1]), cvtpk(s1[2], s1[3]), cvtpk(s1[4], s1[5]), cvtpk(s1[6], s1[7])};
                  w3 = (u32x4){cvtpk(s1[8], s1[9]), cvtpk(s1[10], s1[11]), cvtpk(s1[12], s1[13]), cvtpk(s1[14], s1[15])};
                  pa[0] = __builtin_bit_cast(bf16x8, w0); pa[1] = __builtin_bit_cast(bf16x8, w1); pa[2] = __builtin_bit_cast(bf16x8, w2); pa[3] = __builtin_bit_cast(bf16x8, w3); }
#pragma unroll
                for (int dvb = 0; dvb < 4; ++dvb) {
                    bf16x8 vf[4];
#pragma unroll
                    for (int ks = 0; ks < 4; ++ks) { const s16x4 lo = vtr(vb + dvb * 4096 + ks * 1024), hh = vtr(vb + dvb * 4096 + ks * 1024 + 512);
                        vf[ks] = (bf16x8){lo[0], lo[1], lo[2], lo[3], hh[0], hh[1], hh[2], hh[3]}; }
#pragma unroll
                    for (int ks = 0; ks < 4; ++ks) O[dvb] = MIX_MFMA32(pa[ks], vf[ks], O[dvb]);
                }
            }
            asm volatile("s_waitcnt lgkmcnt(0)" ::: "memory");
            __builtin_amdgcn_s_barrier(); asm volatile("" ::: "memory");
        }
        lsum = xor32_sum(lsum);
        LAS float* Wq = (LAS float*)(lds + TAB_OFF) + wave * 32;
        if (hi == 0) Wq[r32] = (m == 0) ? (1.0f / lsum) : (lam / lsum);
        asm volatile("s_waitcnt lgkmcnt(0)" ::: "memory");
        float sc[16];
#pragma unroll
        for (int r = 0; r < 16; ++r) sc[r] = Wq[crow(r, hi)];
        LAS unsigned char* X = lds + (size_t)qsub * 16384 + lane * 64;
        if (m == 1) {
#pragma unroll
            for (int dvb = 0; dvb < 4; ++dvb)
#pragma unroll
                for (int q4 = 0; q4 < 4; ++q4) *(LAS f32x4*)(X + dvb * 4096 + q4 * 16) = (f32x4){O[dvb][q4 * 4] * sc[q4 * 4], O[dvb][q4 * 4 + 1] * sc[q4 * 4 + 1], O[dvb][q4 * 4 + 2] * sc[q4 * 4 + 2], O[dvb][q4 * 4 + 3] * sc[q4 * 4 + 3]};
        }
        asm volatile("s_waitcnt lgkmcnt(0)" ::: "memory");
        __builtin_amdgcn_s_barrier(); asm volatile("" ::: "memory");
        if (m == 0) {
            float ss[16];
#pragma unroll
            for (int r = 0; r < 16; ++r) ss[r] = 0.f;
#pragma unroll
            for (int dvb = 0; dvb < 4; ++dvb)
#pragma unroll
                for (int q4 = 0; q4 < 4; ++q4) {
                    const f32x4 x1 = *(const LAS f32x4*)(X + dvb * 4096 + q4 * 16);
#pragma unroll
                    for (int e = 0; e < 4; ++e) { const int r = q4 * 4 + e; const float o = O[dvb][r] * sc[r] - x1[e]; O[dvb][r] = o; ss[r] += o * o; }
                }
#pragma unroll
            for (int r = 0; r < 16; ++r) { float v = ss[r]; v += dpp_f<0xB1>(v); v += dpp_f<0x4E>(v); v += dpp_f<0x141>(v); v += dpp_f<0x140>(v); v += xor16_f(v);
                ss[r] = omli / sqrtf(v * (1.f / 128.f) + EPS); }
            asm volatile("s_waitcnt lgkmcnt(0)" ::: "memory");
            LAS bf16_t* stg = (LAS bf16_t*)(lds + (size_t)qsub * 16384);
#pragma unroll
            for (int dvb = 0; dvb < 4; ++dvb) { const float gs = gsub[dvb * 32 + r32];
#pragma unroll
                for (int r = 0; r < 16; ++r) stg[crow(r, hi) * 128 + dvb * 32 + r32] = f2bf(O[dvb][r] * ss[r] * gs); }
            asm volatile("s_waitcnt lgkmcnt(0)" ::: "memory");
            bf16_t* yo = ycat + (size_t)(b * NS + q0 + qsub * 32) * ND + h * 128;
#pragma unroll
            for (int i = 0; i < 8; ++i) { const int row = i * 4 + (lane >> 4), ch = lane & 15;
                const u32x4 v = *(const LAS u32x4*)(stg + row * 128 + ch * 8); *(u32x4*)(yo + (size_t)row * ND + ch * 8) = v; }
        }
        asm volatile("s_waitcnt lgkmcnt(0)" ::: "memory");
        __builtin_amdgcn_s_barrier(); asm volatile("" ::: "memory");
    }
}

constexpr int DL_ACC = 65536;
template <int MODE>
__device__ __forceinline__ void dil_span(Frame& F, int b, int h, int sp, const bf16_t* Z, bf16_t* ycat, float negCb) {
    LAS unsigned char* lds = F.lds;
    const int lane = F.lane, wave = F.wave, r32 = lane & 31, hi = lane >> 5, tid = F.tid;
    const bf16_t* Zb = Z + (size_t)b * NS * INW;
    const int P0 = sp * 256;
    LAS float* Oacc = (LAS float*)(lds + DL_ACC); LAS float* Lacc = (LAS float*)(lds + TAB_OFF);
    LAS unsigned char* vt = lds + wave * 8192;
    const int vrd = ((lane >> 4) & 1) * 32 + (lane & 3) * 8 + (4 * hi + ((lane & 15) >> 2)) * 64;
#define DL_ITEM(k, sh, r, j0, nv, T0, T1) do { if ((k) == 0) { sh = 0; r = 0; j0 = P0 + 32 * wave; nv = 32; } else if ((k) == 1) { sh = 2; r = wave >> 1; j0 = (P0 >> 2) + 32 * (wave & 1); nv = 32; } \
        else { sh = 4; r = 2 * wave + ((k) - 2); j0 = P0 >> 4; nv = 16; } T0 = max(j0 - 128, 0) >> 6; T1 = (j0 + nv - 1) >> 6; } while (0)
#define DL_LOAD(sh, r, T, Kx, Vx) do { const int Lm1_ = (NS >> (sh)) - 1; \
        _Pragma("unroll") for (int i_ = 0; i_ < 8; ++i_) { const int jk_ = min(64 * (T) + 8 * i_ + (lane >> 3), Lm1_); const bf16_t* rp_ = Zb + (size_t)((r) + (jk_ << (sh))) * INW + h * 64 + (lane & 7) * 8; \
            Kx[i_] = *(const u32x4*)(rp_ + 2048); Vx[i_] = *(const u32x4*)(rp_ + 2304); } } while (0)
#define DL_LOADQ(sh, r, j0, Qx) do { const int jq_ = min((j0) + r32, (NS >> (sh)) - 1); const bf16_t* qp_ = Zb + (size_t)((r) + (jq_ << (sh))) * INW + 1792 + h * 64 + hi * 8; \
        _Pragma("unroll") for (int d0 = 0; d0 < 4; ++d0) Qx[d0] = *(const bf16x8*)(qp_ + d0 * 16); } while (0)
    int k = 0, sh, r, j0, nvalid, T0, T1;
    DL_ITEM(0, sh, r, j0, nvalid, T0, T1);
    int T = T0;
    bf16x8 qr[4], qn[4]; u32x4 Kc[8], Kn[8], Vc[8], Vn[8];
    DL_LOADQ(sh, r, j0, qr); DL_LOAD(sh, r, T, Kc, Vc);
#pragma unroll
    for (int d0 = 0; d0 < 4; ++d0) qn[d0] = qr[d0];
    f32x16 O[2];
#pragma unroll
    for (int d = 0; d < 2; ++d)
#pragma unroll
        for (int rr = 0; rr < 16; ++rr) O[d][rr] = 0.f;
    float lsum = 0.f;
#pragma unroll 1
    for (;;) {
        if (MODE == 1) break;
        const bool item_end = (T == T1);
        const int kn = item_end ? k + 1 : k;
        const bool has_next = kn < 4;
        int shn = sh, rn = r, j0n = j0, nvn = nvalid, T0n = T0, T1n = T1, Tn = T + 1;
        if (item_end && has_next) { DL_ITEM(kn, shn, rn, j0n, nvn, T0n, T1n); Tn = T0n; }
#pragma unroll
        for (int i = 0; i < 8; ++i) *(LAS u32x4*)(vt + (8 * i + (lane >> 3)) * 128 + (((lane & 7) ^ ((lane >> 3) & 7)) * 16)) = Kc[i];
        if (has_next && MODE != 2) { DL_LOAD(shn, rn, Tn, Kn, Vn); if (item_end) DL_LOADQ(shn, rn, j0n, qn); }
        f32x16 s0, s1;
#pragma unroll
        for (int rr = 0; rr < 16; ++rr) { s0[rr] = negCb; s1[rr] = negCb; }
        { bf16x8 kf[8];
#pragma unroll
          for (int d0 = 0; d0 < 4; ++d0) { const int ko = ((2 * d0 + hi) ^ (r32 & 7)) * 16;
              kf[d0] = *(const LAS bf16x8*)(vt + r32 * 128 + ko); kf[4 + d0] = *(const LAS bf16x8*)(vt + (32 + r32) * 128 + ko); }
#pragma unroll
          for (int d0 = 0; d0 < 4; ++d0) { s0 = MIX_MFMA32(kf[d0], qr[d0], s0); s1 = MIX_MFMA32(kf[4 + d0], qr[d0], s1); } }
        asm volatile("s_waitcnt lgkmcnt(0)" ::: "memory");
#pragma unroll
        for (int i = 0; i < 8; ++i) *(LAS u32x4*)(vt + (((lane & 7) >> 2) * 4 + (i >> 1)) * 1024 + (8 * (i & 1) + (lane >> 3)) * 64 + (lane & 3) * 16) = Vc[i];
        { const int jq = j0 + r32, kb = 64 * T + 4 * hi; const bool rowok = r32 < nvalid;
#pragma unroll
          for (int rr = 0; rr < 16; ++rr) { const int jk = kb + (rr & 3) + 8 * (rr >> 2);
              const int dd0 = jq - jk, dd1 = dd0 - 32;
              if (!(rowok && dd0 >= 0 && dd0 <= 128)) s0[rr] = -INFINITY;
              if (!(rowok && dd1 >= 0 && dd1 <= 128)) s1[rr] = -INFINITY; } }
        float ls = 0.f;
#pragma unroll
        for (int rr = 0; rr < 16; ++rr) { s0[rr] = __builtin_amdgcn_exp2f(s0[rr]); s1[rr] = __builtin_amdgcn_exp2f(s1[rr]); ls += s0[rr] + s1[rr]; }
        lsum += ls;
        bf16x8 pa[4];
        { u32x4 w0, w1, w2, w3;
          w0 = (u32x4){cvtpk(s0[0], s0[1]), cvtpk(s0[2], s0[3]), cvtpk(s0[4], s0[5]), cvtpk(s0[6], s0[7])};
          w1 = (u32x4){cvtpk(s0[8], s0[9]), cvtpk(s0[10], s0[11]), cvtpk(s0[12], s0[13]), cvtpk(s0[14], s0[15])};
          w2 = (u32x4){cvtpk(s1[0], s1[1]), cvtpk(s1[2], s1[3]), cvtpk(s1[4], s1[5]), cvtpk(s1[6], s1[7])};
          w3 = (u32x4){cvtpk(s1[8], s1[9]), cvtpk(s1[10], s1[11]), cvtpk(s1[12], s1[13]), cvtpk(s1[14], s1[15])};
          pa[0] = __builtin_bit_cast(bf16x8, w0); pa[1] = __builtin_bit_cast(bf16x8, w1); pa[2] = __builtin_bit_cast(bf16x8, w2); pa[3] = __builtin_bit_cast(bf16x8, w3); }
#pragma unroll
        for (int dvb = 0; dvb < 2; ++dvb) {
#pragma unroll
            for (int ks = 0; ks < 4; ++ks) { const s16x4 lo = vtr(vt + vrd + dvb * 4096 + ks * 1024), hh = vtr(vt + vrd + dvb * 4096 + ks * 1024 + 512);
                const bf16x8 vf = (bf16x8){lo[0], lo[1], lo[2], lo[3], hh[0], hh[1], hh[2], hh[3]};
                O[dvb] = MIX_MFMA32(pa[ks], vf, O[dvb]); }
        }
        asm volatile("s_waitcnt lgkmcnt(0)" ::: "memory");
        if (item_end && MODE == 3) { asm volatile("" :: "v"(O[0]), "v"(O[1]), "v"(lsum)); }
        if (item_end && MODE != 3) {
            lsum = xor32_sum(lsum);
            { const int prel = r + ((j0 + r32) << sh) - P0;
              if (hi == 0 && r32 < nvalid) Lacc[prel] = (k == 0) ? lsum : (Lacc[prel] + lsum); }
#pragma unroll
            for (int rr = 0; rr < 16; ++rr) { const int row = crow(rr, hi);
                if (row < nvalid) { const int prel = r + ((j0 + row) << sh) - P0;
#pragma unroll
                    for (int dvb = 0; dvb < 2; ++dvb) { LAS float* ap = Oacc + prel * 64 + dvb * 32 + r32; *ap = (k == 0) ? O[dvb][rr] : (*ap + O[dvb][rr]); } } }
            asm volatile("s_waitcnt lgkmcnt(0)" ::: "memory");
            __builtin_amdgcn_s_barrier(); asm volatile("" ::: "memory");
#pragma unroll
            for (int d = 0; d < 2; ++d)
#pragma unroll
                for (int rr = 0; rr < 16; ++rr) O[d][rr] = 0.f;
            lsum = 0.f;
#pragma unroll
            for (int d0 = 0; d0 < 4; ++d0) qr[d0] = qn[d0];
        }
        if (!has_next) break;
        if (MODE != 2) {
#pragma unroll
        for (int i = 0; i < 8; ++i) { Kc[i] = Kn[i]; Vc[i] = Vn[i]; } }
        k = kn; sh = shn; r = rn; j0 = j0n; nvalid = nvn; T0 = T0n; T1 = T1n; T = Tn;
    }
#undef DL_ITEM
#undef DL_LOAD
#undef DL_LOADQ
    asm volatile("s_waitcnt lgkmcnt(0)" ::: "memory");
    __builtin_amdgcn_s_barrier(); asm volatile("" ::: "memory");
    { const int pos = tid >> 1, dh = (tid & 1) * 32;
      const float inv = 1.0f / Lacc[pos];
      bf16_t* yo = ycat + (size_t)(b * NS + P0 + pos) * ND + 768 + h * 64 + dh;
#pragma unroll
      for (int c4 = 0; c4 < 4; ++c4) { const f32x4 a = *(const LAS f32x4*)(Oacc + pos * 64 + dh + c4 * 8), c = *(const LAS f32x4*)(Oacc + pos * 64 + dh + c4 * 8 + 4);
          u32x4 w; w.x = cvtpk(a[0] * inv, a[1] * inv); w.y = cvtpk(a[2] * inv, a[3] * inv); w.z = cvtpk(c[0] * inv, c[1] * inv); w.w = cvtpk(c[2] * inv, c[3] * inv);
          *(u32x4*)(yo + c4 * 8) = w; } }
    asm volatile("s_waitcnt lgkmcnt(0)" ::: "memory");
    __builtin_amdgcn_s_barrier(); asm volatile("" ::: "memory");
}

constexpr int PL_PITCH = 528;
__device__ __forceinline__ void pool_tile(Frame& F, int tile, const bf16_t* Z, bf16_t* ycat, const float* w_pool, const float* b_pool, const float* pool_scale) {
    LAS unsigned char* lds = F.lds;
    const int lane = F.lane, wave = F.wave, r32 = lane & 31, hi = lane >> 5, tid = F.tid;
    const int row0 = tile * 64, pos0 = row0 & (NS - 1);
    {
        const int c = tid & 255, th = tid >> 8, g = c >> 6, win = 2 << g;
        const int ps = pos0 + 32 * th;
        const bf16_t* up = Z + (size_t)(row0 - pos0) * INW + 1536 + c;
        float s = 0.f;
        for (int p = max(ps - win, 0); p < ps; ++p) s += bf2f(up[(size_t)p * INW]);
#pragma unroll 4
        for (int i = 0; i < 32; ++i) {
            const int p = ps + i;
            const float u = bf2f(up[(size_t)p * INW]);
            s += u;
            if (p - win >= 0) s -= bf2f(up[(size_t)(p - win) * INW]);
            const float cnt = (float)min(p + 1, win);
            *(LAS bf16_t*)(lds + (32 * th + i) * PL_PITCH + c * 2) = f2bf(s / cnt - u);
        }
    }
    asm volatile("s_waitcnt lgkmcnt(0)" ::: "memory");
    __builtin_amdgcn_s_barrier(); asm volatile("" ::: "memory");
    {
        const int g = wave >> 1, mb = wave & 1;
        bf16x8 af[4];
#pragma unroll
        for (int ks = 0; ks < 4; ++ks) af[ks] = *(const LAS bf16x8*)(lds + (32 * mb + r32) * PL_PITCH + (64 * g + 16 * ks + 8 * hi) * 2);
#pragma unroll
        for (int nb = 0; nb < 2; ++nb) {
            f32x16 acc;
#pragma unroll
            for (int rr = 0; rr < 16; ++rr) acc[rr] = 0.f;
            const int e = 32 * nb + r32;
#pragma unroll
            for (int ks = 0; ks < 4; ++ks) {
                const float* wp = w_pool + g * 4096 + (16 * ks + 8 * hi) * 64 + e;
                u32x4 w; w.x = pk2(wp[0], wp[64]); w.y = pk2(wp[128], wp[192]); w.z = pk2(wp[256], wp[320]); w.w = pk2(wp[384], wp[448]);
                acc = MIX_MFMA32(af[ks], __builtin_bit_cast(bf16x8, w), acc);
            }
            const float bb = b_pool[g * 64 + e], ps = pool_scale[g * 64 + e];
            bf16_t* yo = ycat + (size_t)(row0 + 32 * mb) * ND + 512 + 64 * g + e;
#pragma unroll
            for (int rr = 0; rr < 16; ++rr) yo[(size_t)crow(rr, hi) * ND] = f2bf((acc[rr] + bb) * ps);
        }
    }
    asm volatile("s_waitcnt lgkmcnt(0)" ::: "memory");
    __builtin_amdgcn_s_barrier(); asm volatile("" ::: "memory");
}
#undef MIX_MFMA32
}

constexpr int PH_FINAL = 15, PH_END = 16;
#ifndef REP_PHASE
#define REP_PHASE -1
#endif
#ifndef REP_COUNT
#define REP_COUNT 1
#endif
#define NREP(t) ((REP_PHASE == (t)) ? REP_COUNT : 1)
#ifndef DIL_MODE
#define DIL_MODE 0
#endif
__global__ void __launch_bounds__(NWAVES * 64, 2) fwd_kernel(Params P) {
    extern __shared__ __attribute__((aligned(16))) unsigned char lds_raw[];
    Frame F;
    F.lds = (LAS unsigned char*)lds_raw;
    F.tid = threadIdx.x; F.lane = F.tid & 63; F.wave = __builtin_amdgcn_readfirstlane(F.tid >> 6);
    F.G = gridDim.x; { const int bx = blockIdx.x; F.vcu = (F.G % 8 == 0) ? (bx % 8) * (F.G / 8) + bx / 8 : bx; }
    F.in = P.in; F.out = P.out; F.ws = P.ws;
    volatile LAS unsigned* MISC = (volatile LAS unsigned*)(F.lds + MISC_OFF);
    if (F.tid < 64) MISC[F.tid] = 0u;
    __syncthreads();
    unsigned* ctl = (unsigned*)(P.ws + WS_CTL);
    const int lo = P.ph_lo, hi = P.ph_hi;
    const bool multi = (hi - lo) > 1;
    XcdBarrier bar; bar.bar = ctl + CW_BAR; bar.x = 0; bar.st = nullptr;
    if (multi) bar = xcd_barrier_post(ctl + CW_BAR, MISC + 8);
#ifdef ONLY_PHASE
#define IN(k) ((((k) == 0 || (k) == PH_FINAL) ? (k) : (((k) - 1) % 7 + 1)) == ONLY_PHASE && lo <= (k) && (k) < hi)
#else
#define IN(k) (lo <= (k) && (k) < hi)
#endif
#define SEAM(k) do { if (IN(k) && IN((k) + 1)) { for (int rb_ = 0; rb_ < NREP(9); ++rb_) xcd_barrier(bar); } } while (0)
#define FRESH() do { int t_ = threadIdx.x; asm volatile("" : "+v"(t_)); F.tid = t_; F.lane = t_ & 63; F.wave = __builtin_amdgcn_readfirstlane(t_ >> 6); \
        unsigned char* w_ = P.ws; asm volatile("" : "+s"(w_)); F.ws = w_; mod = (float*)(w_ + WS_MOD); HB = (bf16_t*)(w_ + WS_HB); ZB = (bf16_t*)(w_ + WS_ZB); YM = ZB; } while (0)
    float* mod; bf16_t *HB, *ZB, *YM;

    if (IN(0)) { for (int rep_ = 0; rep_ < NREP(0); ++rep_) { FRESH(); p0_prologue(F); } }
    SEAM(0);
    for (int l = 0; l < NL; ++l) {
        const int base = 1 + 7 * l;
        if (IN(base + 0)) { FRESH(); const float* modl = mod + (size_t)l * NB * NMOD;
            if (l == 0) for (int rep_ = 0; rep_ < NREP(1); ++rep_) ln_rows<0, 1>(F, P.in[I_X], nullptr, nullptr, nullptr, P.in[I_GN1] + l * ND, modl, 0, 1024, HB);
            else {
                for (int rep_ = 1; rep_ < NREP(10); ++rep_) { FRESH(); ln_rows<1, 1>(F, P.out, (float*)(F.ws + WS_END), YM, mod + (size_t)(l - 1) * NB * NMOD + 5120, P.in[I_GN1] + l * ND, mod + (size_t)l * NB * NMOD, 0, 1024, HB); }
                ln_rows<1, 1>(F, P.out, P.out, YM, mod + (size_t)(l - 1) * NB * NMOD + 5120, P.in[I_GN1] + l * ND, modl, 0, 1024, HB);
            }
        }
        SEAM(base + 0);
        if (IN(base + 1)) { FRESH();
            pg8::Gemm g{HB, (const bf16_t*)(F.ws + WS_WIN) + (size_t)l * INW * ND, ND};
            pg8::StaticOrder S; S.init(NT, INW, F.G, (int)blockIdx.x);
            pg8::EpiInProj E{ZB, (const float*)(F.ws + WS_GAINS) + l * 256, (const float*)(F.ws + WS_COS), (const float*)(F.ws + WS_SIN)};
            for (int rep_ = 0; rep_ < NREP(2); ++rep_) { FRESH(); pg8::gemm_phase<pg8::EpiInProj, pg8::StaticOrder, true, false>(F.lds, F.tid, g, S, E); }
        }
        SEAM(base + 1);
        if (IN(base + 2)) { FRESH();
            const float* lamv = (const float*)(F.ws + WS_LAM);
            const float lam = lamv[2 * l], omli = 1.0f - lamv[2 * l + 1], negCb = -lamv[16 + 2 * l];
            for (int rep_ = 0; rep_ < NREP(30); ++rep_)
            for (int u = F.vcu; u < NB * 4 * 8; u += F.G) { FRESH();
                mix::da_unit(F, u >> 5, (u >> 3) & 3, u & 7, ZB, HB, lam, omli, negCb, P.in[I_GSUBA] + l * 128); }
            { const float negCc = -lamv[16 + 2 * l + 1];
              for (int rep_ = 1; rep_ < NREP(31); ++rep_) for (int u = F.vcu; u < NB * 4 * 8; u += F.G) { FRESH(); mix::dil_span<DIL_MODE>(F, u >> 5, (u >> 3) & 3, u & 7, ZB, HB, negCc); }
              for (int u = F.vcu; u < NB * 4 * 8; u += F.G) { FRESH(); mix::dil_span<0>(F, u >> 5, (u >> 3) & 3, u & 7, ZB, HB, negCc); } }
            for (int rep_ = 0; rep_ < NREP(32); ++rep_) for (int u = F.vcu; u < NT / 64; u += F.G) { FRESH(); mix::pool_tile(F, u, ZB, HB, P.in[I_WPOOL] + l * 16384, P.in[I_BPOOL] + l * 256, P.in[I_PSCALE] + l * 256); }
        }
        SEAM(base + 2);
        if (IN(base + 3)) { FRESH();
            pg8::Gemm g{HB, (const bf16_t*)(F.ws + WS_WOUT) + (size_t)l * ND * ND, ND};
            pg8::StaticOrder S; S.init(NT, ND, F.G, (int)blockIdx.x);
            pg8::EpiResid E{(l == 0) ? P.in[I_X] : P.out, P.out, mod + (size_t)l * NB * NMOD + 2048};
            for (int rep_ = 0; rep_ < ((l == 0) ? NREP(4) : 1); ++rep_) { FRESH(); pg8::gemm_phase<pg8::EpiResid, pg8::StaticOrder, false, false>(F.lds, F.tid, g, S, E); }
        }
        SEAM(base + 3);
        if (IN(base + 4)) {
            for (int rep_ = 1; rep_ < NREP(5); ++rep_) { FRESH(); router_phase(F, l, 2 + rep_, P.out, mod + (size_t)l * NB * NMOD, HB); }
            FRESH(); router_phase(F, l, l, P.out, mod + (size_t)l * NB * NMOD, HB); }
        SEAM(base + 4);
        if (IN(base + 5)) { FRESH();
            for (int rep_ = 0; rep_ < NREP(6); ++rep_)
            for (int first = 0;; first += 4) { FRESH();
                const int nl = build_group_tables(F, l, 2, first, true);
                if (nl == 0) break;
                pg8::GroupedOrder S{(const LAS int*)(F.lds + TAB_OFF), (const LAS unsigned*)(F.lds + TAB_ROWS_OFF), nl};
                pg8::Gemm g{HB, (const bf16_t*)(F.ws + WS_WUP) + (size_t)l * NEXP * 512 * ND, ND};
                pg8::EpiSwiGLU E{(bf16_t*)(F.ws + WS_HID)};
                pg8::gemm_phase<pg8::EpiSwiGLU, pg8::GroupedOrder, false, true>(F.lds, F.tid, g, S, E);
                if (nl < 4) break;
            }
        }
        SEAM(base + 5);
        if (IN(base + 6)) { FRESH();
            for (int rep_ = 0; rep_ < NREP(7); ++rep_)
            for (int first = 0;; first += 4) { FRESH();
                const int nl = build_group_tables(F, l, 4, first, false);
                if (nl == 0) break;
                pg8::GroupedOrder S{(const LAS int*)(F.lds + TAB_OFF), nullptr, nl};
                pg8::Gemm g{(const bf16_t*)(F.ws + WS_HID), (const bf16_t*)(F.ws + WS_WDN) + (size_t)l * NEXP * ND * NF, NF};
                pg8::EpiScatter E{YM, (const LAS int*)(F.lds + TAB_ROWS_OFF), (const LAS float*)(F.lds + TAB_ROWS2_OFF)};
                pg8::gemm_phase<pg8::EpiScatter, pg8::GroupedOrder, false, false>(F.lds, F.tid, g, S, E);
                if (nl < 4) break;
            }
        }
        SEAM(base + 6);
    }
    if (IN(PH_FINAL)) { for (int rep_ = 1; rep_ < NREP(8); ++rep_) { FRESH(); ln_rows<1, 0>(F, P.out, (float*)(F.ws + WS_END), YM, mod + (size_t)(NL - 1) * NB * NMOD + 5120, nullptr, nullptr, 0, 0, nullptr); } }
    if (IN(PH_FINAL)) { FRESH(); ln_rows<1, 0>(F, P.out, P.out, YM, mod + (size_t)(NL - 1) * NB * NMOD + 5120, nullptr, nullptr, 0, 0, nullptr); }
#undef IN
#undef SEAM
}

static void launch_phases(const Params& base, int lo, int hi, int grid, hipStream_t stream) {
    Params p = base; p.ph_lo = lo; p.ph_hi = hi;
    hipLaunchKernelGGL(fwd_kernel, dim3(grid), dim3(NWAVES * 64), LDS_BYTES, stream, p);
}

extern "C" void kernel_launch(void* const* d_in, const int* in_sizes, int n_in, void* d_out, int out_size, void* d_ws, size_t ws_size, hipStream_t stream) {
    static int grid = 0;
    if (grid == 0) {
        int dev = 0, cus = 0;
        hipGetDevice(&dev);
        hipDeviceGetAttribute(&cus, hipDeviceAttributeMultiprocessorCount, dev);
        hipFuncSetAttribute((const void*)fwd_kernel, hipFuncAttributeMaxDynamicSharedMemorySize, LDS_BYTES);
        (void)hipGetLastError();
        grid = cus > 0 ? cus : 256;
    }
    hipMemsetAsync((char*)d_ws + WS_CTL, 0, CTL_ZERO_BYTES, stream);
    Params P{};
    for (int i = 0; i < 24; ++i) P.in[i] = (const float*)d_in[i];
    P.out = (float*)d_out; P.ws = (unsigned char*)d_ws;

#ifdef MULTI_LAUNCH
    for (int ph = 0; ph < PH_END; ++ph) launch_phases(P, ph, ph + 1, grid, stream);
#else
    launch_phases(P, 0, PH_END, grid, stream);
#endif
}
```

```cpp
#include <hip/hip_runtime.h>
#include <math.h>
#include <stdint.h>

constexpr int NB = 8, NS = 2048, ND = 1024, NT = NB * NS, NL = 2;
constexpr int INW = 2560, NMOD = 6144, NEXP = 32, NF = 256;
constexpr float EPS = 1e-6f;
constexpr float QSCALE = 0.125f * 1.4426950408889634f;

#define LAS __attribute__((address_space(3)))
#define GAS __attribute__((address_space(1)))
typedef unsigned short bf16_t;
typedef short bf16x8 __attribute__((ext_vector_type(8)));
typedef float f32x4 __attribute__((ext_vector_type(4)));
typedef float f32x16 __attribute__((ext_vector_type(16)));
typedef unsigned u32x4 __attribute__((ext_vector_type(4)));
typedef unsigned u32x2 __attribute__((ext_vector_type(2)));

__device__ const double ROPE_REV[32] = {
1.59154943091895345608e-01, 1.19349370211248861917e-01, 8.94994016088910132600e-02, 6.71150830052272551196e-02,
5.03292121044870352509e-02, 3.77415847174197710556e-02, 2.83021958306233986646e-02, 2.12236527647776604399e-02,
1.59154943091895338669e-02, 1.19349370211248861917e-02, 8.94994016088910236684e-03, 6.71150830052272533849e-03,
5.03292121044870369856e-03, 3.77415847174197719230e-03, 2.83021958306233986646e-03, 2.12236527647776621747e-03,
1.59154943091895334333e-03, 1.19349370211248848907e-03, 8.94994016088910128263e-04, 6.71150830052272490481e-04,
5.03292121044870326488e-04, 3.77415847174197686704e-04, 2.83021958306233954120e-04, 2.12236527647776605484e-04,
1.59154943091895323490e-04, 1.19349370211248848907e-04, 8.94994016088910182474e-05, 6.71150830052272544691e-05,
5.03292121044870353593e-05, 3.77415847174197700256e-05, 2.83021958306233960897e-05, 2.12236527647776591931e-05};

__device__ __forceinline__ float bf2f(bf16_t v) { return __uint_as_float(((unsigned)v) << 16); }
__device__ __forceinline__ unsigned f2bf_u(float f) { unsigned u = __float_as_uint(f); return (u + 0x7fffu + ((u >> 16) & 1u)) >> 16; }
__device__ __forceinline__ bf16_t f2bf(float f) { return (bf16_t)f2bf_u(f); }
__device__ __forceinline__ unsigned pk2(float lo, float hi) { return f2bf_u(lo) | (f2bf_u(hi) << 16); }
template <int CTRL> __device__ __forceinline__ float dpp_f(float v) { return __int_as_float(__builtin_amdgcn_update_dpp(0, __float_as_int(v), CTRL, 0xf, 0xf, true)); }
__device__ __forceinline__ float xor16_f(float v) { return __int_as_float(__builtin_amdgcn_ds_swizzle(__float_as_int(v), 0x401F)); }
__device__ __forceinline__ float xor32_sum(float v) { auto r = __builtin_amdgcn_permlane32_swap(__float_as_uint(v), __float_as_uint(v), false, false); return __uint_as_float(r[0]) + __uint_as_float(r[1]); }
__device__ __forceinline__ float sum_fq(float v) { v += xor16_f(v); return xor32_sum(v); }
__device__ __forceinline__ float wave_sum(float v) {
    v += dpp_f<0xB1>(v); v += dpp_f<0x4E>(v); v += dpp_f<0x141>(v); v += dpp_f<0x140>(v); v += xor16_f(v);
    return xor32_sum(v);
}
__device__ __forceinline__ float wave_max(float v) {
    v = fmaxf(v, dpp_f<0xB1>(v)); v = fmaxf(v, dpp_f<0x4E>(v)); v = fmaxf(v, dpp_f<0x141>(v)); v = fmaxf(v, dpp_f<0x140>(v)); v = fmaxf(v, xor16_f(v));
    auto r = __builtin_amdgcn_permlane32_swap(__float_as_uint(v), __float_as_uint(v), false, false); return fmaxf(__uint_as_float(r[0]), __uint_as_float(r[1]));
}

constexpr size_t MiB = 1u << 20;
constexpr size_t WS_CTL = 0, CTL_ZERO_BYTES = 1 * MiB;
constexpr size_t WS_MOD = 1 * MiB;
constexpr size_t WS_COS = 1 * MiB + 512 * 1024, WS_SIN = 1 * MiB + 768 * 1024;
constexpr size_t WS_LAM = 2 * MiB;
constexpr size_t WS_GAINS = 2 * MiB + 4096;
constexpr size_t WS_SELW = 2 * MiB + 64 * 1024;
constexpr size_t WS_WRT = 2 * MiB + 512 * 1024;
constexpr size_t WS_PERM = 3 * MiB;
constexpr size_t WS_WIN = 6 * MiB;
constexpr size_t WS_WOUT = 16 * MiB;
constexpr size_t WS_WUP = 20 * MiB;
constexpr size_t WS_WDN = 84 * MiB;
constexpr size_t WS_HB = 116 * MiB;
constexpr size_t WS_ZB = 148 * MiB;
constexpr size_t WS_HID = 228 * MiB;
constexpr size_t WS_END = 248 * MiB;
constexpr int CW_BAR = 4096;
constexpr int CW_STAT = 65536;
constexpr int CW_CNT = 8192;

namespace pg8 {
constexpr int BM = 256, BK = 64, HALF = 128, HTB = HALF * BK * 2  , STAGE_BYTES = 8 * HTB, NXCD = 8, WGM = 8;

__host__ __device__ __forceinline__ int lds_byte(int r, int c) { const int st = (r >> 4) * 2 + (c >> 5), rr = r & 15, cc = c & 31, ob = rr * 64 + cc * 2; return st * 1024 + (ob ^ (((ob >> 9) & 1) << 5)); }
__host__ __device__ __forceinline__ void stage_rc(int b, int& R, int& C) { const int st = b / 1024, sb = b % 1024, swz = sb ^ (((sb >> 9) & 1) << 5); R = (st >> 1) * 16 + swz / 64; C = (st & 1) * 32 + (swz % 64) / 2; }
__host__ __device__ __forceinline__ int perm32(int rho) { const int n = rho >> 4, i = rho & 15; return 8 * (i >> 2) + 4 * n + (i & 3); }

struct Unit { int pm, pn, aux; };
struct Gemm { const bf16_t* A; const bf16_t* Bt; int K; };

struct StaticOrder {
    int nM, nN, nwg, G, c;
    __device__ void init(int M, int N, int G_, int c_) { nM = M / BM; nN = N / BM; nwg = nM * nN; G = G_; c = c_; }
    __device__ bool next(int i, Unit& u) const {
        const long L = (long)i * G + c; if (L >= nwg) return false;
        int wgid = (int)L; { const int q = nwg / NXCD, r = nwg % NXCD, xcd = wgid % NXCD, off = wgid / NXCD; wgid = (xcd < r ? xcd * (q + 1) : r * (q + 1) + (xcd - r) * q) + off; }
        const int nig = WGM * nN, gid = wgid / nig, fm = gid * WGM, gsz = (nM - fm) < WGM ? (nM - fm) : WGM;
        u.pm = fm + ((wgid % nig) % gsz); u.pn = (wgid % nig) / gsz; u.aux = 0; return true;
    }
    __device__ __forceinline__ unsigned a_off(int, int) const { return 0u; }
};
struct GroupedOrder {
    const LAS int* tab;
    const LAS unsigned* rowoff;
    int n_local;
    __device__ __forceinline__ bool next(int i, Unit& u) const { if (i >= n_local) return false; u.pm = tab[i * 4]; u.pn = tab[i * 4 + 1]; u.aux = i; return true; }
    __device__ __forceinline__ unsigned a_off(int i, int rr) const { return rowoff[i * 256 + rr]; }
};

template <class Epi, class Sched, bool ALIGN_EPI, bool GATHER>
__device__ __forceinline__ void gemm_phase(LAS unsigned char* lds, const int tid, const Gemm g, const Sched& S, const Epi& E) {
    const int wid = __builtin_amdgcn_readfirstlane(tid >> 6), lane = tid & 63, wr = wid >> 2, wc = wid & 3, fr = lane & 15, fq = lane >> 4;
    const int K = g.K, nt = K / BK;
    unsigned voffA[2], voffB[2]; int Rrow[2];
#pragma unroll
    for (int i = 0; i < 2; ++i) { int R, C; stage_rc(tid * 16 + i * 8192, R, C); const int Rb = Epi::PERM ? ((R & ~31) + perm32(R & 31)) : R;
        voffA[i] = GATHER ? (unsigned)(C * 2) : (unsigned)(R * K + C) * 2u; voffB[i] = (unsigned)(Rb * K + C) * 2u; Rrow[i] = R; }
    const size_t kstep = (size_t)(BK * 2);
    const size_t hstep = (size_t)HALF * K * 2;
    const size_t hstepA = GATHER ? 0 : hstep;
    const size_t tstep = 2 * hstep;
    const unsigned ldsw = (unsigned)wid * 1024u;
    const int aoff = lds_byte(wr * 64 + fr, fq * 8), boff = lds_byte(wc * 32 + fr, fq * 8);
#define PG8_SA(b, h) (((b) * 2 + (h)) * HTB)
#define PG8_SB(b, h) ((4 + (b) * 2 + (h)) * HTB)
#define PG8_STAGE(bufoff, gbase, voff) do { _Pragma("unroll") for (int _i = 0; _i < 2; ++_i) \
        __builtin_amdgcn_global_load_lds((const unsigned*)((const char*)(gbase) + (voff)[_i]), (LAS unsigned*)(lds + (bufoff) + ldsw + _i * 8192), 16, 0, 0); } while (0)
#define PG8_LDA(dst, b, h) do { _Pragma("unroll") for (int m = 0; m < 4; ++m) _Pragma("unroll") for (int k = 0; k < 2; ++k) dst[m][k] = *(const LAS bf16x8*)(lds + PG8_SA(b, h) + aoff + m * 2048 + k * 1024); } while (0)
#define PG8_LDB(dst, b, h) do { _Pragma("unroll") for (int n = 0; n < 2; ++n) _Pragma("unroll") for (int k = 0; k < 2; ++k) dst[n][k] = *(const LAS bf16x8*)(lds + PG8_SB(b, h) + boff + n * 2048 + k * 1024); } while (0)
#define PG8_MMA(ai, bj, At, Bt) do { __builtin_amdgcn_s_setprio(1); _Pragma("unroll") for (int m = 0; m < 4; ++m) _Pragma("unroll") for (int n = 0; n < 2; ++n) _Pragma("unroll") for (int k = 0; k < 2; ++k) \
        acc[ai][bj][m][n] = __builtin_amdgcn_mfma_f32_16x16x32_bf16(Bt[n][k], At[m][k], acc[ai][bj][m][n], 0, 0, 0); __builtin_amdgcn_s_setprio(0); } while (0)
#define PG8_WAIT_V(n) asm volatile("s_waitcnt vmcnt(" #n ")" ::: "memory")
#define PG8_WAIT_L(n) asm volatile("s_waitcnt lgkmcnt(" #n ")" ::: "memory")
#define PG8_BAR __builtin_amdgcn_s_barrier()
#define PG8_SCHED __builtin_amdgcn_sched_barrier(0)
    Unit cur, nxt; int ui = 0;
    if (!S.next(0, cur)) return;
    f32x4 acc[2][2][4][2];
#pragma unroll
    for (int a = 0; a < 2; ++a)
#pragma unroll
        for (int b = 0; b < 2; ++b)
#pragma unroll
            for (int m = 0; m < 4; ++m)
#pragma unroll
                for (int n = 0; n < 2; ++n) acc[a][b][m][n] = (f32x4){0.f, 0.f, 0.f, 0.f};
    bf16x8 At[4][2], B0[2][2], B1[2][2];
    unsigned vAc0[2], vAc1[2], vAn0[2], vAn1[2];
#pragma unroll
    for (int i = 0; i < 2; ++i) {
        if (GATHER) { vAc0[i] = S.a_off(cur.aux, Rrow[i]) + voffA[i]; vAc1[i] = S.a_off(cur.aux, HALF + Rrow[i]) + voffA[i]; }
        else { vAc0[i] = voffA[i]; vAc1[i] = voffA[i]; }
        vAn0[i] = vAc0[i]; vAn1[i] = vAc1[i];
    }
    const char* cA = (const char*)g.A + (GATHER ? (size_t)0 : (size_t)cur.pm * tstep); const char* cB = (const char*)g.Bt + (size_t)cur.pn * tstep;
    PG8_STAGE(PG8_SB(0, 0), cB, voffB); PG8_STAGE(PG8_SB(0, 1), cB + hstep, voffB); PG8_STAGE(PG8_SA(0, 0), cA, vAc0); PG8_STAGE(PG8_SA(0, 1), cA + hstepA, vAc1);
    if (wr == 1) PG8_BAR;
    PG8_WAIT_V(2); PG8_BAR;
    PG8_STAGE(PG8_SB(1, 0), cB + kstep, voffB); PG8_STAGE(PG8_SA(1, 0), cA + kstep, vAc0); PG8_STAGE(PG8_SB(1, 1), cB + hstep + kstep, voffB);
    PG8_WAIT_V(6); PG8_BAR;
    for (;;) {
        const bool has_next = S.next(ui + 1, nxt);
        const char* nA = has_next ? (const char*)g.A + (GATHER ? (size_t)0 : (size_t)nxt.pm * tstep) : cA; const char* nB = has_next ? (const char*)g.Bt + (size_t)nxt.pn * tstep : cB;
        if (GATHER) {
#pragma unroll
            for (int i = 0; i < 2; ++i) {
                if (has_next) { vAn0[i] = S.a_off(nxt.aux, Rrow[i]) + voffA[i]; vAn1[i] = S.a_off(nxt.aux, HALF + Rrow[i]) + voffA[i]; }
                else { vAn0[i] = vAc0[i]; vAn1[i] = vAc1[i]; }
            }
        }
#pragma unroll 1
        for (int t = 0; t < nt; t += 2) {
            const bool last = (t == nt - 2);
            const char* a1 = cA + (size_t)(t + 1) * kstep;
            const char* a2 = last ? nA : cA + (size_t)(t + 2) * kstep; const char* b2 = last ? nB : cB + (size_t)(t + 2) * kstep;
            const char* a3 = a2 + kstep; const char* b3 = b2 + kstep;
            unsigned vs0[2], vs1[2];
#pragma unroll
            for (int i = 0; i < 2; ++i) { vs0[i] = (GATHER && last) ? vAn0[i] : vAc0[i]; vs1[i] = (GATHER && last) ? vAn1[i] : vAc1[i]; }
            PG8_LDB(B0, 0, 0); PG8_LDB(B1, 0, 1); PG8_SCHED; PG8_LDA(At, 0, 0); PG8_STAGE(PG8_SA(1, 1), a1 + hstepA, vAc1);
            PG8_WAIT_V(8); PG8_WAIT_L(0); PG8_BAR; PG8_MMA(0, 0, At, B0); PG8_MMA(0, 1, At, B1); PG8_BAR; PG8_SCHED;
            PG8_LDA(At, 0, 1); PG8_STAGE(PG8_SB(0, 0), b2, voffB); PG8_STAGE(PG8_SB(0, 1), b2 + hstep, voffB); PG8_STAGE(PG8_SA(0, 0), a2, vs0);
            PG8_WAIT_V(8); PG8_WAIT_L(0); PG8_BAR; PG8_MMA(1, 0, At, B0); PG8_MMA(1, 1, At, B1); PG8_BAR; PG8_SCHED;
            PG8_LDB(B0, 1, 0); PG8_LDB(B1, 1, 1); PG8_SCHED; PG8_LDA(At, 1, 0); PG8_STAGE(PG8_SA(0, 1), a2 + hstepA, vs1);
            PG8_WAIT_V(8); PG8_WAIT_L(0); PG8_BAR; PG8_MMA(0, 0, At, B0); PG8_MMA(0, 1, At, B1); PG8_BAR; PG8_SCHED;
            PG8_LDA(At, 1, 1); PG8_STAGE(PG8_SB(1, 0), b3, voffB); PG8_STAGE(PG8_SB(1, 1), b3 + hstep, voffB); PG8_STAGE(PG8_SA(1, 0), a3, vs0);
            PG8_WAIT_V(8); PG8_WAIT_L(0); PG8_BAR; PG8_MMA(1, 0, At, B0); PG8_MMA(1, 1, At, B1); PG8_BAR; PG8_SCHED;
        }
        if constexpr (ALIGN_EPI) { if (wr == 0) PG8_BAR; }
        E(acc, cur, wr, wc, fr, fq);
        if (!has_next) break;
#pragma unroll
        for (int a = 0; a < 2; ++a)
#pragma unroll
            for (int b = 0; b < 2; ++b)
#pragma unroll
                for (int m = 0; m < 4; ++m)
#pragma unroll
                    for (int n = 0; n < 2; ++n) acc[a][b][m][n] = (f32x4){0.f, 0.f, 0.f, 0.f};
        cur = nxt; cA = nA; cB = nB; ++ui;
#pragma unroll
        for (int i = 0; i < 2; ++i) { vAc0[i] = vAn0[i]; vAc1[i] = vAn1[i]; }
        if constexpr (ALIGN_EPI) { if (wr == 1) PG8_BAR; }
    }
    PG8_WAIT_V(0);
    if constexpr (!ALIGN_EPI) { if (wr == 0) PG8_BAR; }
    PG8_BAR;
#undef PG8_SA
#undef PG8_SB
#undef PG8_STAGE
#undef PG8_LDA
#undef PG8_LDB
#undef PG8_MMA
#undef PG8_WAIT_V
#undef PG8_WAIT_L
#undef PG8_BAR
#undef PG8_SCHED
}

__device__ __forceinline__ unsigned cvt_pk_bf16(float lo, float hi) { unsigned r; asm volatile("v_cvt_pk_bf16_f32 %0, %1, %2" : "=v"(r) : "v"(lo), "v"(hi)); return r; }

struct EpiInProj {
    static constexpr bool PERM = true;
    bf16_t* Z; const float *gains  , *cosT, *sinT;
    __device__ __forceinline__ void operator()(const f32x4 (&acc)[2][2][4][2], const Unit& u, int wr, int wc, int fr, int fq) const {
        const int pn = u.pn;
        const int row0 = u.pm * BM + wr * 64 + fr;
        const int colbase = pn * 256 + wc * 64 + 8 * fq;
        const bool normed = (pn < 4) || (pn == 7) || (pn == 8);
        if (normed) {
            const int gi = (pn < 2) ? 0 : (pn < 4) ? 1 : (pn == 7) ? 2 : 3;
            const float* gain = gains + gi * 64;
            const float qs = (pn < 2 || pn == 7) ? QSCALE : 1.0f;
            f32x4 g[2][2];
#pragma unroll
            for (int bj = 0; bj < 2; ++bj)
#pragma unroll
                for (int n = 0; n < 2; ++n) g[bj][n] = *(const f32x4*)(gain + 32 * bj + 8 * fq + 4 * n) * qs;
#pragma unroll
            for (int ai = 0; ai < 2; ++ai)
#pragma unroll
                for (int m = 0; m < 4; ++m) {
                    const int row = row0 + ai * HALF + m * 16, pos = row & (NS - 1);
                    float ss = 0.f;
#pragma unroll
                    for (int bj = 0; bj < 2; ++bj)
#pragma unroll
                        for (int n = 0; n < 2; ++n) { const f32x4 v = acc[ai][bj][m][n]; ss += (v[0] * v[0] + v[1] * v[1]) + (v[2] * v[2] + v[3] * v[3]); }
                    ss = sum_fq(ss);
                    const float rstd = 1.0f / sqrtf(ss * (1.f / 64.f) + EPS);
                    u32x4 wlo, whi;
#pragma unroll
                    for (int n = 0; n < 2; ++n) {
                        const f32x4 c = *(const f32x4*)(cosT + pos * 32 + 8 * fq + 4 * n), s = *(const f32x4*)(sinT + pos * 32 + 8 * fq + 4 * n);
                        const f32x4 lo = acc[ai][0][m][n] * rstd * g[0][n], hi = acc[ai][1][m][n] * rstd * g[1][n];
                        const f32x4 olo = lo * c - hi * s, ohi = hi * c + lo * s;
                        wlo[2 * n] = cvt_pk_bf16(olo[0], olo[1]); wlo[2 * n + 1] = cvt_pk_bf16(olo[2], olo[3]);
                        whi[2 * n] = cvt_pk_bf16(ohi[0], ohi[1]); whi[2 * n + 1] = cvt_pk_bf16(ohi[2], ohi[3]);
                    }
                    bf16_t* rowp = Z + (size_t)row * INW + colbase;
                    *(u32x4*)(rowp) = wlo; *(u32x4*)(rowp + 32) = whi;
                    asm volatile("" ::: "memory");
                }
        } else {
#pragma unroll
            for (int ai = 0; ai < 2; ++ai)
#pragma unroll
                for (int m = 0; m < 4; ++m) {
                    bf16_t* rowp = Z + (size_t)(row0 + ai * HALF + m * 16) * INW + colbase;
#pragma unroll
                    for (int bj = 0; bj < 2; ++bj) { const f32x4 v0 = acc[ai][bj][m][0], v1 = acc[ai][bj][m][1];
                        u32x4 w; w.x = cvt_pk_bf16(v0[0], v0[1]); w.y = cvt_pk_bf16(v0[2], v0[3]); w.z = cvt_pk_bf16(v1[0], v1[1]); w.w = cvt_pk_bf16(v1[2], v1[3]);
                        *(u32x4*)(rowp + 32 * bj) = w; }
                }
        }
    }
};
struct EpiResid {
    static constexpr bool PERM = false;
    const float* resid; float* out; const float* ga;
    __device__ __forceinline__ void operator()(const f32x4 (&acc)[2][2][4][2], const Unit& u, int wr, int wc, int fr, int fq) const {
        const int row0 = u.pm * BM + wr * 64 + fr, col0 = u.pn * BM + wc * 32 + 4 * fq;
        const int b = (u.pm * BM) / NS;
        f32x4 gv[2][2];
#pragma unroll
        for (int bj = 0; bj < 2; ++bj)
#pragma unroll
            for (int n = 0; n < 2; ++n) gv[bj][n] = *(const f32x4*)(ga + (size_t)b * NMOD + col0 + bj * HALF + n * 16);
#pragma unroll
        for (int ai = 0; ai < 2; ++ai)
#pragma unroll
            for (int m = 0; m < 4; ++m) { const size_t off = (size_t)(row0 + ai * HALF + m * 16) * ND + col0;
#pragma unroll
                for (int bj = 0; bj < 2; ++bj)
#pragma unroll
                    for (int n = 0; n < 2; ++n) { const f32x4 r = *(const f32x4*)(resid + off + bj * HALF + n * 16); *(f32x4*)(out + off + bj * HALF + n * 16) = r + gv[bj][n] * acc[ai][bj][m][n]; } }
    }
};
struct EpiSwiGLU {
    static constexpr bool PERM = true;
    bf16_t* hid;
    __device__ __forceinline__ void operator()(const f32x4 (&acc)[2][2][4][2], const Unit& u, int wr, int wc, int fr, int fq) const {
        const int row0 = u.pm * BM + wr * 64 + fr, f0 = (u.pn & 1) * 128 + wc * 16 + 4 * fq;
#pragma unroll
        for (int ai = 0; ai < 2; ++ai)
#pragma unroll
            for (int m = 0; m < 4; ++m) { bf16_t* rowp = hid + (size_t)(row0 + ai * HALF + m * 16) * NF + f0;
#pragma unroll
                for (int bj = 0; bj < 2; ++bj) { const f32x4 a = acc[ai][bj][m][0], c = acc[ai][bj][m][1]; f32x4 h;
#pragma unroll
                    for (int j = 0; j < 4; ++j) h[j] = a[j] * __builtin_amdgcn_rcpf(1.0f + __expf(-a[j])) * c[j];
                    u32x2 w; w.x = cvt_pk_bf16(h[0], h[1]); w.y = cvt_pk_bf16(h[2], h[3]);
                    *(u32x2*)(rowp + 64 * bj) = w; }
            }
    }
};
struct EpiScatter {
    static constexpr bool PERM = true;
    bf16_t* ym;
    const LAS int* rdest; const LAS float* rcw;
    __device__ __forceinline__ void operator()(const f32x4 (&acc)[2][2][4][2], const Unit& u, int wr, int wc, int fr, int fq) const {
        const int col0 = (u.pn & 3) * 256 + wc * 32 + 8 * fq;
#pragma unroll
        for (int ai = 0; ai < 2; ++ai)
#pragma unroll
            for (int m = 0; m < 4; ++m) {
                const int r = ai * HALF + wr * 64 + m * 16 + fr;
                const int dest = rdest[u.aux * 256 + r]; const float cw = rcw[u.aux * 256 + r];
                if (dest >= 0) {
                    bf16_t* rowp = ym + (size_t)dest * ND + col0;
#pragma unroll
                    for (int bj = 0; bj < 2; ++bj) {
                        const f32x4 v0 = acc[ai][bj][m][0] * cw, v1 = acc[ai][bj][m][1] * cw;
                        u32x4 w; w.x = cvt_pk_bf16(v0[0], v0[1]); w.y = cvt_pk_bf16(v0[2], v0[3]); w.z = cvt_pk_bf16(v1[0], v1[1]); w.w = cvt_pk_bf16(v1[2], v1[3]);
                        *(u32x4*)(rowp + bj * HALF) = w; }
                }
                asm volatile("" ::: "memory");
            }
    }
};
}

constexpr int NWAVES = 8;
constexpr int RING_BYTES = 131072;
constexpr int TAB_OFF = RING_BYTES;
constexpr int TAB_BYTES = 14336;
constexpr int MISC_OFF = TAB_OFF + TAB_BYTES;
constexpr int LDS_BYTES = 147456;
static_assert(MISC_OFF + 256 <= LDS_BYTES, "LDS map");

typedef GAS unsigned gu32;
#define RLX_AGENT __ATOMIC_RELAXED, __HIP_MEMORY_SCOPE_AGENT
#define LDS_WAIT() asm volatile("s_waitcnt lgkmcnt(0)" ::: "memory")
#define VM_WAIT() asm volatile("s_waitcnt vmcnt(0)" ::: "memory")

#define XB_TMO      128
#define XB_XCNT(j)  (256  + 64 * (j))
#define XB_XSUB(j)  (1280 + 64 * (j))
#define XB_XGEN(j)  (2304 + 64 * (j))
#define XB_TOP      3328
#define XB_TOPGEN   3392
#define XCD_BAR_WORDS 3456
#define XB_SPIN_CAP (1u << 18)
__device__ __forceinline__ unsigned xb_ld(unsigned* p)              { return __hip_atomic_load(p, __ATOMIC_RELAXED, __HIP_MEMORY_SCOPE_AGENT); }
__device__ __forceinline__ unsigned xb_add(unsigned* p, unsigned v) { return __hip_atomic_fetch_add(p, v, __ATOMIC_RELAXED, __HIP_MEMORY_SCOPE_AGENT); }
__device__ __forceinline__ unsigned xb_xcc_id() { return (unsigned)__builtin_amdgcn_s_getreg((3 << 11) | 20) & 0xFu; }
#define XB_SPIN(cond, bar) do { unsigned _sp = 0; while (cond) { __builtin_amdgcn_s_sleep(1); \
    if ((++_sp & 255u) == 0u) { if (xb_ld(&(bar)[XB_TMO])) break; if (_sp > XB_SPIN_CAP) { atomicAdd(&(bar)[XB_TMO], 1u); break; } } } } while (0)
struct XcdBarrier { unsigned* bar; unsigned x; volatile LAS unsigned* st; };
__device__ __forceinline__ XcdBarrier xcd_barrier_post(unsigned* bar, volatile LAS unsigned* st) {
    XcdBarrier b; b.bar = bar; b.x = xb_xcc_id(); b.st = st;
    if (threadIdx.x == 0) (void)xb_add(&bar[XB_XCNT(b.x)], 1u);
    return b;
}
__device__ __forceinline__ void xcd_barrier_complete(unsigned* bar, unsigned x, unsigned& nloc, unsigned& nx) {
    const unsigned G = gridDim.x * gridDim.y * gridDim.z;
    unsigned sum, cnt, mine, sp = 0u;
    for (;;) {
        sum = 0u; cnt = 0u; mine = 0u;
#pragma unroll
        for (unsigned j = 0; j < 16; ++j) { const unsigned c = xb_ld(&bar[XB_XCNT(j)]); sum += c; cnt += (c > 0u) ? 1u : 0u; mine = (j == x) ? c : mine; }
        if (sum == G) break;
        __builtin_amdgcn_s_sleep(1);
        if ((++sp & 255u) == 0u) { if (xb_ld(&bar[XB_TMO])) break; if (sp > XB_SPIN_CAP) { atomicAdd(&bar[XB_TMO], 1u); break; } }
    }
    nloc = mine > 0u ? mine : 1u; nx = cnt > 0u ? cnt : 1u;
}
__device__ __forceinline__ void xcd_barrier(const XcdBarrier& b) {
    asm volatile("s_waitcnt vmcnt(0)" ::: "memory");
    __syncthreads();
    if (threadIdx.x == 0) {
        unsigned* bar = b.bar;
        __builtin_amdgcn_s_waitcnt(0);
        unsigned nloc = b.st[0], nx = b.st[1];
        if (nloc == 0u) { xcd_barrier_complete(bar, b.x, nloc, nx); b.st[0] = nloc; b.st[1] = nx; }
        const unsigned old = xb_add(&bar[XB_XSUB(b.x)], 1u);
        const unsigned gen = old / nloc;
        if (old + 1u == (gen + 1u) * nloc) {
            __builtin_amdgcn_fence(__ATOMIC_RELEASE, "agent");
            asm volatile("s_waitcnt vmcnt(0)" ::: "memory");
            const unsigned og = xb_add(&bar[XB_TOP], 1u);
            const unsigned tg = og / nx;
            if (og + 1u == (tg + 1u) * nx) xb_add(&bar[XB_TOPGEN], 1u);
            else XB_SPIN(xb_ld(&bar[XB_TOPGEN]) == tg, bar);
            __builtin_amdgcn_fence(__ATOMIC_ACQUIRE, "agent");
            xb_add(&bar[XB_XGEN(b.x)], 1u);
            asm volatile("s_waitcnt vmcnt(0)" ::: "memory");
        } else {
            XB_SPIN(xb_ld(&bar[XB_XGEN(b.x)]) == gen, bar);
            __builtin_amdgcn_fence(__ATOMIC_ACQUIRE, "agent");
            asm volatile("s_waitcnt vmcnt(0)" ::: "memory");
        }
    }
    __syncthreads();
}

struct Params { const float* in[24]; float* out; unsigned char* ws; int ph_lo, ph_hi; };
enum { I_X = 0, I_C, I_WMOD, I_BMOD, I_GN1, I_WIN, I_GQA, I_GKA, I_LAMA, I_GSUBA, I_WPOOL, I_BPOOL, I_PSCALE, I_GQC, I_GKC, I_WOUT, I_GN2, I_WRG, I_BRG, I_WRE, I_BRE, I_W1, I_W3, I_W2 };

struct Frame {
    LAS unsigned char* lds;
    int tid, lane, wave, vcu, G;
    const float* const* in; float* out; unsigned char* ws;
};

struct MapIn  { __device__ __forceinline__ int operator()(int n) const { return (n & ~255) + ((n >> 5) & 1) * 128 + ((n >> 6) & 3) * 32 + (n & 31); } };
struct MapId  { __device__ __forceinline__ int operator()(int n) const { return n; } };
struct MapUp  { int which; __device__ __forceinline__ int operator()(int f) const { return (f >> 7) * 256 + ((f >> 6) & 1) * 128 + ((f >> 4) & 3) * 32 + ((f >> 2) & 3) * 8 + which * 4 + (f & 3); } };

__device__ __forceinline__ void p0_prologue(Frame& F) {
    LAS float* scr = (LAS float*)(F.lds + F.wave * 8704);
    const int gw = F.vcu * NWAVES + F.wave, NGW = F.G * NWAVES;
    {
        LAS float* cond = (LAS float*)(F.lds + 98304);
        LAS float* red = (LAS float*)(F.lds + 73728);
        for (int i = F.tid; i < NB * ND; i += NWAVES * 64) { const float v = F.in[I_C][i]; cond[i] = v / (1.f + __expf(-v)); }
        __syncthreads();
        for (int it = F.vcu; it < NL * (NMOD / 64); it += F.G) {
            const int l = it / (NMOD / 64), j = (it % (NMOD / 64)) * 64 + F.lane;
            const float* w = F.in[I_WMOD] + (size_t)l * ND * NMOD + (size_t)F.wave * 128 * NMOD + j;
            const LAS float* cd = cond + F.wave * 128;
            float acc[NB];
#pragma unroll
            for (int b = 0; b < NB; ++b) acc[b] = 0.f;
#pragma unroll 1
            for (int d0 = 0; d0 < 128; d0 += 16) {
                float wv[16];
#pragma unroll
                for (int q = 0; q < 16; ++q) wv[q] = w[(size_t)(d0 + q) * NMOD];
#pragma unroll
                for (int q4 = 0; q4 < 4; ++q4)
#pragma unroll
                    for (int b = 0; b < NB; ++b) { const f32x4 c4 = *(const LAS f32x4*)(cd + b * ND + d0 + 4 * q4);
                        acc[b] += (c4[0] * wv[4 * q4] + c4[1] * wv[4 * q4 + 1]) + (c4[2] * wv[4 * q4 + 2] + c4[3] * wv[4 * q4 + 3]); }
            }
#pragma unroll
            for (int b = 0; b < NB; ++b) red[(F.wave * NB + b) * 64 + F.lane] = acc[b];
            __syncthreads();
            { const int b = F.wave; float tot = 0.f;
#pragma unroll
              for (int w8 = 0; w8 < 8; ++w8) tot += red[(w8 * NB + b) * 64 + F.lane];
              ((float*)(F.ws + WS_MOD))[(size_t)(l * NB + b) * NMOD + j] = tot + F.in[I_BMOD][l * NMOD + j]; }
            __syncthreads();
        }
    }
    {
        float* cosT = (float*)(F.ws + WS_COS); float* sinT = (float*)(F.ws + WS_SIN);
        for (int idx = gw * 64 + F.lane; idx < NS * 32; idx += NGW * 64) {
            const int t = idx >> 5, i = idx & 31;
            double r = (double)t * ROPE_REV[i]; r = r - rint(r);
            const float rf = (float)r;
            cosT[idx] = __builtin_amdgcn_cosf(rf); sinT[idx] = __builtin_amdgcn_sinf(rf);
        }
        if (gw == NGW - 2) {
            float* gains = (float*)(F.ws + WS_GAINS);
            for (int l = 0; l < NL; ++l) {
                gains[(l * 4 + 0) * 64 + F.lane] = F.in[I_GQA][l * 64 + F.lane]; gains[(l * 4 + 1) * 64 + F.lane] = F.in[I_GKA][l * 64 + F.lane];
                gains[(l * 4 + 2) * 64 + F.lane] = F.in[I_GQC][l * 64 + F.lane]; gains[(l * 4 + 3) * 64 + F.lane] = F.in[I_GKC][l * 64 + F.lane];
            }
        }
        if (gw == NGW - 3) {
            float* bnd = (float*)(F.ws + WS_LAM) + 16;
            for (int l = 0; l < NL; ++l) {
                const float qa = wave_max(fabsf(F.in[I_GQA][l * 64 + F.lane])), ka = wave_max(fabsf(F.in[I_GKA][l * 64 + F.lane]));
                const float qc = wave_max(fabsf(F.in[I_GQC][l * 64 + F.lane])), kc = wave_max(fabsf(F.in[I_GKC][l * 64 + F.lane]));
                if (F.lane == 0) { bnd[l * 2] = 64.f * QSCALE * qa * ka * 1.01f + 0.25f; bnd[l * 2 + 1] = 64.f * QSCALE * qc * kc * 1.01f + 0.25f; }
            }
        }
        {
            float* wrt = (float*)(F.ws + WS_WRT);
            for (int it = gw; it < NL * 36; it += NGW) {
                const int l = it / 36, n = it % 36;
                for (int d = F.lane; d < ND; d += 64)
                    wrt[(size_t)it * ND + d] = (n < 4) ? F.in[I_WRG][((size_t)l * ND + d) * 4 + n] : F.in[I_WRE][(((size_t)l * 4 + ((n - 4) >> 3)) * ND + d) * 8 + ((n - 4) & 7)];
            }
        }
        if (gw == NGW - 1) {
            float* lamv = (float*)(F.ws + WS_LAM);
            for (int l = 0; l < NL; ++l) {
                const float* lp = F.in[I_LAMA] + l * 256;
                const float a = wave_sum(lp[F.lane] * lp[64 + F.lane]);
                const float b = wave_sum(lp[128 + F.lane] * lp[192 + F.lane]);
                const float lam_init = 0.8f - 0.6f * expf(-0.3f * (float)l);
                if (F.lane == 0) { lamv[2 * l] = expf(a) - expf(b) + lam_init; lamv[2 * l + 1] = lam_init; }
            }
        }
    }
    {
        bf16_t* win = (bf16_t*)(F.ws + WS_WIN); bf16_t* wout = (bf16_t*)(F.ws + WS_WOUT); bf16_t* wup = (bf16_t*)(F.ws + WS_WUP); bf16_t* wdn = (bf16_t*)(F.ws + WS_WDN);
        constexpr int I_IN = NL * (ND / 64) * (INW / 32);
        constexpr int I_OUT = NL * (ND / 64) * (ND / 32);
        constexpr int I_UP = NL * NEXP * (ND / 64) * (NF / 32);
        constexpr int I_DN = NL * NEXP * (NF / 64) * (ND / 32);
        constexpr int NITEMS = I_IN + I_OUT + 2 * I_UP + I_DN;
#define P0_DECODE(it, src, ldw, dst, K, k0, n0, map) do { int r_ = (it); \
            if (r_ < I_IN) { const int l = r_ / (I_IN / NL), q = r_ % (I_IN / NL); k0 = (q / (INW / 32)) * 64; n0 = (q % (INW / 32)) * 32; ldw = INW; K = ND; map = 1; src = F.in[I_WIN] + (size_t)l * ND * INW; dst = win + (size_t)l * INW * ND; } \
            else if ((r_ -= I_IN) < I_OUT) { const int l = r_ / (I_OUT / NL), q = r_ % (I_OUT / NL); k0 = (q / (ND / 32)) * 64; n0 = (q % (ND / 32)) * 32; ldw = ND; K = ND; map = 0; src = F.in[I_WOUT] + (size_t)l * ND * ND; dst = wout + (size_t)l * ND * ND; } \
            else if ((r_ -= I_OUT) < 2 * I_UP) { const int which = r_ / I_UP, q0 = r_ % I_UP, le = q0 / ((ND / 64) * (NF / 32)), q = q0 % ((ND / 64) * (NF / 32)); k0 = (q / (NF / 32)) * 64; n0 = (q % (NF / 32)) * 32; ldw = NF; K = ND; map = 2 + which; \
                src = F.in[which ? I_W3 : I_W1] + (size_t)le * ND * NF; dst = wup + (size_t)le * 512 * ND; } \
            else { r_ -= 2 * I_UP; const int le = r_ / ((NF / 64) * (ND / 32)), q = r_ % ((NF / 64) * (ND / 32)); k0 = (q / (ND / 32)) * 64; n0 = (q % (ND / 32)) * 32; ldw = ND; K = NF; map = 0; src = F.in[I_W2] + (size_t)le * NF * ND; dst = wdn + (size_t)le * ND * NF; } \
            src += (size_t)k0 * ldw + n0; } while (0)
#define P0_LOAD(tv, src, ldw) do { _Pragma("unroll") for (int i = 0; i < 8; ++i) tv[i] = *(const f32x4*)((src) + (size_t)(8 * i + (F.lane >> 3)) * (ldw) + (F.lane & 7) * 4); } while (0)
        const float* src; bf16_t* dst; int ldw, K, k0, n0, map;
        f32x4 tv[8], tn[8];
        int it = gw;
        if (it < NITEMS) { P0_DECODE(it, src, ldw, dst, K, k0, n0, map); P0_LOAD(tv, src, ldw); }
#pragma unroll 1
        for (; it < NITEMS; it += NGW) {
            const float* srcn = src; bf16_t* dstn = dst; int ldwn = ldw, Kn = K, k0n = k0, n0n = n0, mapn = map;
            const bool more = (it + NGW) < NITEMS;
            if (more) { P0_DECODE(it + NGW, srcn, ldwn, dstn, Kn, k0n, n0n, mapn); P0_LOAD(tn, srcn, ldwn); }
#pragma unroll
            for (int i = 0; i < 8; ++i) { LAS float* sp = scr + (8 * i + (F.lane >> 3)) * 33 + (F.lane & 7) * 4; sp[0] = tv[i][0]; sp[1] = tv[i][1]; sp[2] = tv[i][2]; sp[3] = tv[i][3]; }
            LDS_WAIT(); asm volatile("" ::: "memory");
            { const int c = F.lane & 7;
#pragma unroll
              for (int j = 0; j < 4; ++j) { const int n = n0 + (F.lane >> 3) + 8 * j; const LAS float* s = scr + (8 * c) * 33 + (F.lane >> 3) + 8 * j;
                  const int row = (map == 0) ? n : (map == 1) ? MapIn{}(n) : MapUp{map - 2}(n);
                  u32x4 o; o.x = pk2(s[0 * 33], s[1 * 33]); o.y = pk2(s[2 * 33], s[3 * 33]); o.z = pk2(s[4 * 33], s[5 * 33]); o.w = pk2(s[6 * 33], s[7 * 33]);
                  *(GAS u32x4*)(dst + (size_t)row * K + k0 + 8 * c) = o; } }
            LDS_WAIT(); asm volatile("" ::: "memory");
#pragma unroll
            for (int i = 0; i < 8; ++i) tv[i] = tn[i];
            src = srcn; dst = dstn; ldw = ldwn; K = Kn; k0 = k0n; n0 = n0n; map = mapn;
        }
#undef P0_DECODE
#undef P0_LOAD
    }
}

template <int COMBINE, int WRITE_H>
__device__ __forceinline__ void ln_rows(Frame& F, const float* x, float* xw, const bf16_t* ym, const float* ga2  , const float* g, const float* modl, int sh_off, int sc_off, bf16_t* h) {
    const int gw = F.vcu * NWAVES + F.wave, NGW = F.G * NWAVES;
#pragma unroll 1
    for (int row0 = gw; row0 < NT; row0 += 2 * NGW) {
        const bool two = (row0 + NGW) < NT;
        const int rows[2] = {row0, two ? row0 + NGW : row0};
        f32x4 v[2][4]; u32x2 ya[2][4], yc[2][4];
#pragma unroll
        for (int q = 0; q < 2; ++q) {
            const f32x4* xr = (const f32x4*)(x + (size_t)rows[q] * ND) + F.lane;
#pragma unroll
            for (int j = 0; j < 4; ++j) v[q][j] = xr[64 * j];
            if (COMBINE) { const u32x2* y0 = (const u32x2*)(ym + (size_t)rows[q] * 2048) + F.lane;
#pragma unroll
                for (int j = 0; j < 4; ++j) { ya[q][j] = y0[64 * j]; yc[q][j] = y0[256 + 64 * j]; } }
        }
#pragma unroll
        for (int q = 0; q < 2; ++q) {
            if (q == 1 && !two) break;
            const int row = rows[q], b = row / NS;
            if (COMBINE) {
#pragma unroll
                for (int j = 0; j < 4; ++j) { const u32x2 a = ya[q][j], c = yc[q][j];
                    const f32x4 gt = *(const f32x4*)(ga2 + (size_t)b * NMOD + (F.lane + 64 * j) * 4);
                    v[q][j][0] += gt[0] * (__uint_as_float(a.x << 16) + __uint_as_float(c.x << 16)); v[q][j][1] += gt[1] * (__uint_as_float(a.x & 0xffff0000u) + __uint_as_float(c.x & 0xffff0000u));
                    v[q][j][2] += gt[2] * (__uint_as_float(a.y << 16) + __uint_as_float(c.y << 16)); v[q][j][3] += gt[3] * (__uint_as_float(a.y & 0xffff0000u) + __uint_as_float(c.y & 0xffff0000u));
                    ((f32x4*)(xw + (size_t)row * ND) + F.lane)[64 * j] = v[q][j]; }
            }
            if (WRITE_H) {
                float ss = 0.f;
#pragma unroll
                for (int j = 0; j < 4; ++j) ss += (v[q][j][0] * v[q][j][0] + v[q][j][1] * v[q][j][1]) + (v[q][j][2] * v[q][j][2] + v[q][j][3] * v[q][j][3]);
                ss = wave_sum(ss);
                const float rstd = 1.0f / sqrtf(ss * (1.f / ND) + EPS);
                const float* mb = modl + (size_t)b * NMOD;
                u32x2* o8 = (u32x2*)(h + (size_t)row * ND) + F.lane;
#pragma unroll
                for (int j = 0; j < 4; ++j) {
                    const int d = (F.lane + 64 * j) * 4;
                    const f32x4 gg = *(const f32x4*)(g + d), sc = *(const f32x4*)(mb + sc_off + d), sh = *(const f32x4*)(mb + sh_off + d);
                    const f32x4 o = v[q][j] * rstd * gg * (sc + 1.0f) + sh;
                    u32x2 w; w.x = pk2(o[0], o[1]); w.y = pk2(o[2], o[3]); o8[64 * j] = w;
                }
            }
        }
    }
}

template <int RMODE>
__device__ __forceinline__ void router_phase(Frame& F, int l, int lc  , const float* x, const float* modl, bf16_t* h) {
    const int gw = F.vcu * NWAVES + F.wave, NGW = F.G * NWAVES;
    const float* g = F.in[I_GN2] + l * ND;
    const float* wrt = (const float*)(F.ws + WS_WRT) + (size_t)l * 36 * ND;
    const float* b_rg = F.in[I_BRG] + l * 4; const float* b_re = F.in[I_BRE] + l * 32;
    LAS int* lcnt = (LAS int*)(F.lds + TAB_OFF);
    LAS float* lg = (LAS float*)(F.lds + TAB_OFF + 512) + F.wave * 320;
    int* perm = (int*)(F.ws + WS_PERM); float* selw = (float*)(F.ws + WS_SELW);
    unsigned* cntw = (unsigned*)(F.ws + WS_CTL) + CW_CNT + (size_t)lc * 32 * 64;
#pragma unroll 1
    for (int chunk = 0; chunk * 8 * NGW < NT; ++chunk) {
        if (F.tid < 64) lcnt[F.tid] = 0;
        __syncthreads();
        f32x4 v[8][4];
#pragma unroll
        for (int r = 0; r < 8; ++r) {
            const int row = (chunk * 8 + r) * NGW + gw;
            const int b = row / NS;
            const f32x4* xr = (const f32x4*)(x + (size_t)row * ND) + F.lane;
            float ss = 0.f;
#pragma unroll
            for (int j = 0; j < 4; ++j) { v[r][j] = xr[64 * j]; ss += (v[r][j][0] * v[r][j][0] + v[r][j][1] * v[r][j][1]) + (v[r][j][2] * v[r][j][2] + v[r][j][3] * v[r][j][3]); }
            ss = wave_sum(ss);
            const float rstd = 1.0f / sqrtf(ss * (1.f / ND) + EPS);
            const float* mb = modl + (size_t)b * NMOD;
            u32x2* o8 = (u32x2*)(h + (size_t)row * ND) + F.lane;
#pragma unroll
            for (int j = 0; j < 4; ++j) {
                const int d = (F.lane + 64 * j) * 4;
                const f32x4 gg = *(const f32x4*)(g + d), sc = *(const f32x4*)(mb + 4096 + d), sh = *(const f32x4*)(mb + 3072 + d);
                v[r][j] = v[r][j] * rstd * gg * (sc + 1.0f) + sh;
                u32x2 w; w.x = pk2(v[r][j][0], v[r][j][1]); w.y = pk2(v[r][j][2], v[r][j][3]); o8[64 * j] = w;
            }
        }
        const bool b0 = (F.lane & 1) != 0, b1 = (F.lane & 2) != 0, b2 = (F.lane & 4) != 0; const int c8 = F.lane >> 3;
        const int rho = 4 * (F.lane & 1) + 2 * ((F.lane >> 1) & 1) + ((F.lane >> 2) & 1);
#define RT_BUTTERFLY(s8, k1) do { float k4_[4], k2_[2]; \
            _Pragma("unroll") for (int i = 0; i < 4; ++i) { const float keep = b0 ? s8[4 + i] : s8[i], send = b0 ? s8[i] : s8[4 + i]; k4_[i] = keep + dpp_f<0xB1>(send); } \
            _Pragma("unroll") for (int i = 0; i < 2; ++i) { const float keep = b1 ? k4_[2 + i] : k4_[i], send = b1 ? k4_[i] : k4_[2 + i]; k2_[i] = keep + dpp_f<0x4E>(send); } \
            { const float keep = b2 ? k2_[1] : k2_[0], send = b2 ? k2_[0] : k2_[1]; k1 = keep + __int_as_float(__builtin_amdgcn_ds_swizzle(__float_as_int(send), 0x101F)); } \
            k1 += __int_as_float(__builtin_amdgcn_ds_swizzle(__float_as_int(k1), 0x201F)); k1 += xor16_f(k1); k1 = xor32_sum(k1); } while (0)
        if (RMODE == 1) { asm volatile("" :: "v"(v[0][0]), "v"(v[7][3])); continue; }
        __syncthreads();
        { const f32x4* gsrc = (const f32x4*)wrt; for (int i = F.tid; i < 4 * 256; i += NWAVES * 64) ((LAS f32x4*)F.lds)[i] = gsrc[i]; }
        __syncthreads();
        { float lq = 0.f;
#pragma unroll
          for (int c = 0; c < 4; ++c) {
              const LAS f32x4* wp = (const LAS f32x4*)(F.lds + c * 4096) + F.lane;
              const f32x4 w0 = wp[0], w1 = wp[64], w2 = wp[128], w3 = wp[192];
              float s8[8];
#pragma unroll
              for (int r = 0; r < 8; ++r) { const f32x4 p = v[r][0] * w0 + v[r][1] * w1 + v[r][2] * w2 + v[r][3] * w3; s8[r] = (p[0] + p[1]) + (p[2] + p[3]); }
              float k1; RT_BUTTERFLY(s8, k1);
              lq = (c8 == c) ? k1 : lq;
          }
          if (c8 < 4) lg[rho * 40 + c8] = lq; }
        asm volatile("s_waitcnt lgkmcnt(0)" ::: "memory");
        int gsel[8];
#pragma unroll
        for (int r = 0; r < 8; ++r) { float gm = lg[r * 40] + b_rg[0]; int gi = 0;
#pragma unroll
            for (int q = 1; q < 4; ++q) { const float t = lg[r * 40 + q] + b_rg[q]; if (t > gm) { gm = t; gi = q; } }
            gsel[r] = gi; }
        __syncthreads();
        { const f32x4* gsrc = (const f32x4*)(wrt + (size_t)4 * ND); for (int i = F.tid; i < 32 * 256; i += NWAVES * 64) ((LAS f32x4*)F.lds)[i] = gsrc[i]; }
        __syncthreads();
        { float lq = 0.f;
#pragma unroll 2
          for (int e = 0; e < 8; ++e) {
              float s8[8];
#pragma unroll
              for (int r = 0; r < 8; ++r) { const LAS f32x4* wp = (const LAS f32x4*)(F.lds + (gsel[r] * 8 + e) * 4096) + F.lane;
                  const f32x4 p = v[r][0] * wp[0] + v[r][1] * wp[64] + v[r][2] * wp[128] + v[r][3] * wp[192]; s8[r] = (p[0] + p[1]) + (p[2] + p[3]); }
              float k1; RT_BUTTERFLY(s8, k1);
              lq = (c8 == e) ? k1 : lq;
          }
          lg[rho * 40 + 8 + c8] = lq; }
#undef RT_BUTTERFLY
        asm volatile("s_waitcnt lgkmcnt(0)" ::: "memory");
        int e0 = -1, e1 = -1, row2 = 0, rk0 = 0, rk1 = 0; float w0s = 0.f, w1s = 0.f;
        if (F.lane < 8) {
            const int r = F.lane; const LAS float* q = lg + r * 40;
            float gl[4];
#pragma unroll
            for (int gi = 0; gi < 4; ++gi) gl[gi] = q[gi] + b_rg[gi];
            int gidx = 0; float gm = gl[0];
#pragma unroll
            for (int gi = 1; gi < 4; ++gi) if (gl[gi] > gm) { gm = gl[gi]; gidx = gi; }
            float gs = 0.f;
#pragma unroll
            for (int gi = 0; gi < 4; ++gi) gs += expf(gl[gi] - gm);
            const float g_w = 1.0f / gs;
            float el[8];
#pragma unroll
            for (int e = 0; e < 8; ++e) el[e] = q[8 + e] + b_re[gidx * 8 + e];
            int i0 = 0; float v0 = el[0];
#pragma unroll
            for (int e = 1; e < 8; ++e) if (el[e] > v0) { v0 = el[e]; i0 = e; }
            int i1 = -1; float v1 = -INFINITY;
#pragma unroll
            for (int e = 0; e < 8; ++e) if (e != i0 && el[e] > v1) { v1 = el[e]; i1 = e; }
            const float ex = expf(v1 - v0);
            w0s = g_w / (1.0f + ex); w1s = g_w * ex / (1.0f + ex);
            e0 = gidx * 8 + i0; e1 = gidx * 8 + i1; row2 = ((chunk * 8 + r) * NGW + gw) * 2;
            rk0 = __hip_atomic_fetch_add(lcnt + e0, 1, __ATOMIC_RELAXED, __HIP_MEMORY_SCOPE_WORKGROUP);
            rk1 = __hip_atomic_fetch_add(lcnt + e1, 1, __ATOMIC_RELAXED, __HIP_MEMORY_SCOPE_WORKGROUP);
        }
        __syncthreads();
        if (F.tid < 32) { const int c = lcnt[F.tid]; int basev = 0;
            if (c > 0) basev = (int)__hip_atomic_fetch_add(cntw + F.tid * 64, (unsigned)c, __ATOMIC_RELAXED, __HIP_MEMORY_SCOPE_AGENT);
            lcnt[32 + F.tid] = basev; }
        __syncthreads();
        if (e0 >= 0) {
            perm[e0 * 16384 + lcnt[32 + e0] + rk0] = row2;     selw[row2] = w0s;
            perm[e1 * 16384 + lcnt[32 + e1] + rk1] = row2 + 1; selw[row2 + 1] = w1s;
        }
        __syncthreads();
    }
}

constexpr int TAB_ROWS_OFF = TAB_OFF + 512, TAB_ROWS2_OFF = TAB_OFF + 512 + 4096;
__device__ __forceinline__ int build_group_tables(Frame& F, int l, int npn, int first, bool up) {
    LAS int* tab = (LAS int*)(F.lds + TAB_OFF);
    int tid = threadIdx.x; asm volatile("" : "+v"(tid));
    const unsigned* cntw = (const unsigned*)(F.ws + WS_CTL) + CW_CNT + (size_t)l * 32 * 64;
    __syncthreads();
    if (tid < 32) tab[16 + tid] = (int)__hip_atomic_load(cntw + tid * 64, __ATOMIC_RELAXED, __HIP_MEMORY_SCOPE_AGENT);
    __syncthreads();
    if (tid == 0) { int acc = 0; for (int e = 0; e < 32; ++e) { tab[48 + e] = acc; acc += (tab[16 + e] + 255) >> 8; } tab[80] = acc; }
    __syncthreads();
    const int U = tab[80] * npn;
    int n_local = 0;
    for (int i = 0; i < 4; ++i) {
        const int gi = F.vcu + (first + i) * F.G;
        if (gi >= U) break;
        n_local = i + 1;
        const int mtg = gi / npn, pn = gi % npn;
        int e = 0;
        for (int q = 1; q < 32; ++q) if (tab[48 + q] <= mtg) e = q;
        while (e > 0 && ((tab[16 + e] + 255) >> 8) == 0) --e;
        const int mt = mtg - tab[48 + e], cnt = tab[16 + e];
        if (tid == 0) { tab[i * 4] = mtg; tab[i * 4 + 1] = e * npn + pn; tab[i * 4 + 2] = min(256, cnt - mt * 256); tab[i * 4 + 3] = e; }
        if (tid < 256) {
            const int idx = mt * 256 + tid; const bool valid = idx < cnt;
            const int entry = valid ? ((const int*)(F.ws + WS_PERM))[e * 16384 + idx] : 0;
            if (up) ((LAS unsigned*)(F.lds + TAB_ROWS_OFF))[i * 256 + tid] = (unsigned)(entry >> 1) * (unsigned)(ND * 2);
            else { ((LAS int*)(F.lds + TAB_ROWS_OFF))[i * 256 + tid] = valid ? entry : -1; ((LAS float*)(F.lds + TAB_ROWS2_OFF))[i * 256 + tid] = valid ? ((const float*)(F.ws + WS_SELW))[entry] : 0.f; }
        }
    }
    __syncthreads();
    return n_local;
}

namespace mix {
typedef short s16x4 __attribute__((ext_vector_type(4)));
__device__ __forceinline__ int crow(int r, int hi) { return (r & 3) + 8 * (r >> 2) + 4 * hi; }
__device__ __forceinline__ s16x4 vtr(const LAS unsigned char* p) { return __builtin_bit_cast(s16x4, __builtin_amdgcn_ds_read_tr16_b64_v4i16((LAS s16x4*)p)); }
__device__ __forceinline__ unsigned cvtpk(float lo, float hi) { unsigned r; asm volatile("v_cvt_pk_bf16_f32 %0, %1, %2" : "=v"(r) : "v"(lo), "v"(hi)); return r; }
#define MIX_MFMA32(a, b, c) __builtin_amdgcn_mfma_f32_32x32x16_bf16((a), (b), (c), 0, 0, 0)

constexpr int DA_STAGE = 65536, DA_K1 = 16384, DA_V = 32768;
__device__ __forceinline__ void da_stage_load(LAS unsigned char* lds, int buf, const bf16_t* Zb, int h, int key0, int wave, int lane) {
#pragma unroll
    for (int i = 0; i < 8; ++i) {
        const int p = wave * 8 + i;
        const bf16_t* src; int dst;
        if (p < 32) { const int m = p >> 4, q = p & 15, row = 8 * q + (lane >> 3);
            src = Zb + (size_t)(key0 + row) * INW + 512 + h * 128 + m * 64 + (((lane & 7) ^ (row & 7)) * 8);
            dst = buf * DA_STAGE + m * DA_K1 + q * 1024; }
        else { const int q = p - 32, kp = q >> 4, dvb = (q >> 2) & 3, rg = q & 3;
            src = Zb + (size_t)(key0 + kp * 64 + rg * 16 + (lane >> 2)) * INW + 1024 + h * 128 + dvb * 32 + (lane & 3) * 8;
            dst = buf * DA_STAGE + DA_V + kp * 16384 + dvb * 4096 + rg * 1024; }
        __builtin_amdgcn_global_load_lds((const unsigned*)src, (LAS unsigned*)(lds + dst), 16, 0, 0);
    }
}

template <int MODE>
__device__ __forceinline__ void da_unit(Frame& F, int b, int h, int j, const bf16_t* Z, bf16_t* ycat, float lam, float omli, float negCb, const float* gsub) {
    LAS unsigned char* lds = F.lds;
    const int lane = F.lane, wave = F.wave, r32 = lane & 31, hi = lane >> 5, qsub = wave & 3, m = wave >> 2;
    const bf16_t* Zb = Z + (size_t)b * NS * INW;
    const int vrd = ((lane >> 4) & 1) * 32 + (lane & 3) * 8 + (4 * hi + ((lane & 15) >> 2)) * 64;
#pragma unroll 1
    for (int half = 0; half < 2; ++half) {
        const int qb = half ? (15 - j) : j, q0 = qb * 128, nsteps = qb + 1;
        da_stage_load(lds, 0, Zb, h, 0, wave, lane);
        bf16x8 qr[4];
        { const bf16_t* qp = Zb + (size_t)(q0 + qsub * 32 + r32) * INW + h * 128 + m * 64 + hi * 8;
#pragma unroll
          for (int d0 = 0; d0 < 4; ++d0) qr[d0] = *(const bf16x8*)(qp + d0 * 16); }
        f32x16 O[4];
#pragma unroll
        for (int d = 0; d < 4; ++d)
#pragma unroll
            for (int r = 0; r < 16; ++r) O[d][r] = 0.f;
        float lsum = 0.f;
        f32x16 negm;
#pragma unroll
        for (int r = 0; r < 16; ++r) negm[r] = negCb;
        asm volatile("" : "+v"(negm));
#pragma unroll 1
        for (int s = 0; s < nsteps; ++s) {
            const int buf = s & 1;
            if (s + 1 < nsteps) { da_stage_load(lds, buf ^ 1, Zb, h, (s + 1) * 128, wave, lane); asm volatile("s_waitcnt vmcnt(8)" ::: "memory"); }
            else asm volatile("s_waitcnt vmcnt(0)" ::: "memory");
            __builtin_amdgcn_s_barrier(); asm volatile("" ::: "memory");
            const bool diag = (s == qb);
#pragma unroll 1
            for (int kp = 0; kp < 2; ++kp) {
                if (MODE == 4) break;
                if (diag && kp == 1 && qsub < 2) break;
                const LAS unsigned char* kb = lds + buf * DA_STAGE + m * DA_K1 + (kp * 64 + r32) * 128;
                const LAS unsigned char* vb = lds + buf * DA_STAGE + DA_V + kp * 16384 + vrd;
                f32x16 s0, s1;
                { bf16x8 kf[8];
#pragma unroll
                  for (int d0 = 0; d0 < 4; ++d0) { const int ko = ((2 * d0 + hi) ^ (r32 & 7)) * 16; kf[d0] = *(const LAS bf16x8*)(kb + ko); kf[4 + d0] = *(const LAS bf16x8*)(kb + ko + 4096); }
                  __builtin_amdgcn_sched_barrier(0);
                  if (MODE == 3) { s0 = negm; s1 = negm; asm volatile("" :: "v"(kf[0]), "v"(kf[7])); } else {
                  s0 = MIX_MFMA32(kf[0], qr[0], negm); s1 = MIX_MFMA32(kf[4], qr[0], negm);
#pragma unroll
                  for (int d0 = 1; d0 < 4; ++d0) { s0 = MIX_MFMA32(kf[d0], qr[d0], s0); s1 = MIX_MFMA32(kf[4 + d0], qr[d0], s1); } } }
                if (diag) {
                    const int qrel = qsub * 32 + r32, kbase = kp * 64 + 4 * hi;
#pragma unroll
                    for (int r = 0; r < 16; ++r) { const int kv = kbase + (r & 3) + 8 * (r >> 2); if (kv > qrel) s0[r] = -INFINITY; if (kv + 32 > qrel) s1[r] = -INFINITY; }
                }
                float ls = 0.f;
#pragma unroll
                for (int r = 0; r < 16; ++r) { if (MODE != 2) { s0[r] = __builtin_amdgcn_exp2f(s0[r]); s1[r] = __builtin_amdgcn_exp2f(s1[r]); } ls += s0[r] + s1[r]; }
                lsum += ls;
                bf16x8 pa[4];
                { u32x4 w0, w1, w2, w3;
                  w0 = (u32x4){cvtpk(s0[0], s0[1]), cvtpk(s0[2], s0[3]), cvtpk(s0[4], s0[5]), cvtpk(s0[6], s0[7])};
                  w1 = (u32x4){cvtpk(s0[8], s0[9]), cvtpk(s0[10], s0[11]), cvtpk(s0[12], s0[13]), cvtpk(s0[14], s0[15])};
                  w2 = (u32x4){cvtpk(s1[0], s1[1]), cvtpk(s1[2], s1[3]), cvtpk(s1[4], s1[5]), cvtpk(s1[6], s1[7])};
                  w3 = (u32x4){cvtpk(s1[8], s1[9]), cvtpk(s1[10], s1[11]), cvtpk(s1[12], s1[13]), cvtpk(s1[14], s1[15])};
                  pa[0] = __builtin_bit_cast(bf16x8, w0); pa[1] = __builtin_bit_cast(bf16x8, w1); pa[2] = __builtin_bit_cast(bf16x8, w2); pa[3] = __builtin_bit_cast(bf16x8, w3); }
                if (MODE == 1) { asm volatile("" :: "v"(pa[0]), "v"(pa[1]), "v"(pa[2]), "v"(pa[3])); } else
#pragma unroll
                for (int dv2 = 0; dv2 < 2; ++dv2) {
                    bf16x8 vf[8];
#pragma unroll
                    for (int i = 0; i < 8; ++i) { const int dvb = 2 * dv2 + (i >> 2), ks = i & 3; const s16x4 lo = vtr(vb + dvb * 4096 + ks * 1024), hh = vtr(vb + dvb * 4096 + ks * 1024 + 512);
                        vf[i] = (bf16x8){lo[0], lo[1], lo[2], lo[3], hh[0], hh[1], hh[2], hh[3]}; }
                    __builtin_amdgcn_sched_barrier(0);
#pragma unroll
                    for (int i = 0; i < 8; ++i) O[2 * dv2 + (i >> 2)] = MIX_MFMA32(pa[i & 3], vf[i], O[2 * dv2 + (i >> 2)]);
                }
            }
            asm volatile("s_waitcnt lgkmcnt(0)" ::: "memory");
            __builtin_amdgcn_s_barrier(); asm volatile("" ::: "memory");
        }
        int lane_e = threadIdx.x & 63; asm volatile("" : "+v"(lane_e));
        const int lane = lane_e, r32 = lane_e & 31, hi = lane_e >> 5;
        lsum = xor32_sum(lsum);
        LAS float* Wq = (LAS float*)(lds + TAB_OFF) + wave * 32;
        if (hi == 0) Wq[r32] = (m == 0) ? (1.0f / lsum) : (lam / lsum);
        asm volatile("s_waitcnt lgkmcnt(0)" ::: "memory");
        float sc[16];
#pragma unroll
        for (int r = 0; r < 16; ++r) sc[r] = Wq[crow(r, hi)];
        LAS unsigned char* X = lds + (size_t)qsub * 16384 + lane * 64;
        if (m == 1) {
#pragma unroll
            for (int dvb = 0; dvb < 4; ++dvb)
#pragma unroll
                for (int q4 = 0; q4 < 4; ++q4) *(LAS f32x4*)(X + dvb * 4096 + q4 * 16) = (f32x4){O[dvb][q4 * 4] * sc[q4 * 4], O[dvb][q4 * 4 + 1] * sc[q4 * 4 + 1], O[dvb][q4 * 4 + 2] * sc[q4 * 4 + 2], O[dvb][q4 * 4 + 3] * sc[q4 * 4 + 3]};
        }
        asm volatile("s_waitcnt lgkmcnt(0)" ::: "memory");
        __builtin_amdgcn_s_barrier(); asm volatile("" ::: "memory");
        if (m == 0) {
            float ss[16];
#pragma unroll
            for (int r = 0; r < 16; ++r) ss[r] = 0.f;
#pragma unroll
            for (int dvb = 0; dvb < 4; ++dvb)
#pragma unroll
                for (int q4 = 0; q4 < 4; ++q4) {
                    const f32x4 x1 = *(const LAS f32x4*)(X + dvb * 4096 + q4 * 16);
#pragma unroll
                    for (int e = 0; e < 4; ++e) { const int r = q4 * 4 + e; const float o = O[dvb][r] * sc[r] - x1[e]; O[dvb][r] = o; ss[r] += o * o; }
                }
#pragma unroll
            for (int r = 0; r < 16; ++r) { float v = ss[r]; v += dpp_f<0xB1>(v); v += dpp_f<0x4E>(v); v += dpp_f<0x141>(v); v += dpp_f<0x140>(v); v += xor16_f(v);
                ss[r] = omli / sqrtf(v * (1.f / 128.f) + EPS); }
            asm volatile("s_waitcnt lgkmcnt(0)" ::: "memory");
            LAS bf16_t* stg = (LAS bf16_t*)(lds + (size_t)qsub * 16384);
#pragma unroll
            for (int dvb = 0; dvb < 4; ++dvb) { const float gs = gsub[dvb * 32 + r32];
#pragma unroll
                for (int r = 0; r < 16; ++r) stg[crow(r, hi) * 128 + dvb * 32 + r32] = f2bf(O[dvb][r] * ss[r] * gs); }
            asm volatile("s_waitcnt lgkmcnt(0)" ::: "memory");
            bf16_t* yo = ycat + (size_t)(b * NS + q0 + qsub * 32) * ND + h * 128;
#pragma unroll
            for (int i = 0; i < 8; ++i) { const int row = i * 4 + (lane >> 4), ch = lane & 15;
                const u32x4 v = *(const LAS u32x4*)(stg + row * 128 + ch * 8); if (MODE == 0) *(u32x4*)(yo + (size_t)row * ND + ch * 8) = v; else asm volatile("" :: "v"(v)); }
        }
        asm volatile("s_waitcnt lgkmcnt(0)" ::: "memory");
        __builtin_amdgcn_s_barrier(); asm volatile("" ::: "memory");
    }
}

constexpr int DL_ACC = 65536;
template <int MODE>
__device__ __forceinline__ void dil_span(Frame& F, int b, int h, int sp, const bf16_t* Z, bf16_t* ycat, float negCb) {
    LAS unsigned char* lds = F.lds;
    const int lane = F.lane, wave = F.wave, r32 = lane & 31, hi = lane >> 5, tid = F.tid;
    const bf16_t* Zb = Z + (size_t)b * NS * INW;
    const int P0 = sp * 256;
    LAS float* Oacc = (LAS float*)(lds + DL_ACC); LAS float* Lacc = (LAS float*)(lds + TAB_OFF);
    LAS unsigned char* vt = lds + wave * 8192;
    const int vrd = ((lane >> 4) & 1) * 32 + (lane & 3) * 8 + (4 * hi + ((lane & 15) >> 2)) * 64;
#define DL_ITEM(k, sh, r, j0, nv, T0, T1) do { if ((k) == 0) { sh = 0; r = 0; j0 = P0 + 32 * wave; nv = 32; } else if ((k) == 1) { sh = 2; r = wave >> 1; j0 = (P0 >> 2) + 32 * (wave & 1); nv = 32; } \
        else { sh = 4; r = 2 * wave + ((k) - 2); j0 = P0 >> 4; nv = 16; } T0 = max(j0 - 128, 0) >> 6; T1 = (j0 + nv - 1) >> 6; } while (0)
#define DL_LOAD(sh, r, T, Kx, Vx) do { const int Lm1_ = (NS >> (sh)) - 1; \
        _Pragma("unroll") for (int i_ = 0; i_ < 8; ++i_) { const int jk_ = min(64 * (T) + 8 * i_ + (lane >> 3), Lm1_); const bf16_t* rp_ = Zb + (size_t)((r) + (jk_ << (sh))) * INW + h * 64 + (lane & 7) * 8; \
            Kx[i_] = *(const u32x4*)(rp_ + 2048); Vx[i_] = *(const u32x4*)(rp_ + 2304); } } while (0)
#define DL_LOADQ(sh, r, j0, Qx) do { const int jq_ = min((j0) + r32, (NS >> (sh)) - 1); const bf16_t* qp_ = Zb + (size_t)((r) + (jq_ << (sh))) * INW + 1792 + h * 64 + hi * 8; \
        _Pragma("unroll") for (int d0 = 0; d0 < 4; ++d0) Qx[d0] = *(const bf16x8*)(qp_ + d0 * 16); } while (0)
    int k = 0, sh, r, j0, nvalid, T0, T1;
    DL_ITEM(0, sh, r, j0, nvalid, T0, T1);
    int T = T0;
    bf16x8 qr[4], qn[4]; u32x4 Kc[8], Kn[8], Vc[8], Vn[8];
    DL_LOADQ(sh, r, j0, qr); DL_LOAD(sh, r, T, Kc, Vc);
#pragma unroll
    for (int d0 = 0; d0 < 4; ++d0) qn[d0] = qr[d0];
    f32x16 O[2];
#pragma unroll
    for (int d = 0; d < 2; ++d)
#pragma unroll
        for (int rr = 0; rr < 16; ++rr) O[d][rr] = 0.f;
    float lsum = 0.f;
#pragma unroll 1
    for (;;) {
        if (MODE == 1) break;
        const bool item_end = (T == T1);
        const int kn = item_end ? k + 1 : k;
        const bool has_next = kn < 4;
        int shn = sh, rn = r, j0n = j0, nvn = nvalid, T0n = T0, T1n = T1, Tn = T + 1;
        if (item_end && has_next) { DL_ITEM(kn, shn, rn, j0n, nvn, T0n, T1n); Tn = T0n; }
#pragma unroll
        for (int i = 0; i < 8; ++i) *(LAS u32x4*)(vt + (8 * i + (lane >> 3)) * 128 + (((lane & 7) ^ ((lane >> 3) & 7)) * 16)) = Kc[i];
        if (has_next && MODE != 2) { DL_LOAD(shn, rn, Tn, Kn, Vn); if (item_end) DL_LOADQ(shn, rn, j0n, qn); }
        f32x16 s0, s1;
#pragma unroll
        for (int rr = 0; rr < 16; ++rr) { s0[rr] = negCb; s1[rr] = negCb; }
        { bf16x8 kf[8];
#pragma unroll
          for (int d0 = 0; d0 < 4; ++d0) { const int ko = ((2 * d0 + hi) ^ (r32 & 7)) * 16;
              kf[d0] = *(const LAS bf16x8*)(vt + r32 * 128 + ko); kf[4 + d0] = *(const LAS bf16x8*)(vt + (32 + r32) * 128 + ko); }
#pragma unroll
          for (int d0 = 0; d0 < 4; ++d0) { s0 = MIX_MFMA32(kf[d0], qr[d0], s0); s1 = MIX_MFMA32(kf[4 + d0], qr[d0], s1); } }
        asm volatile("s_waitcnt lgkmcnt(0)" ::: "memory");
#pragma unroll
        for (int i = 0; i < 8; ++i) *(LAS u32x4*)(vt + (((lane & 7) >> 2) * 4 + (i >> 1)) * 1024 + (8 * (i & 1) + (lane >> 3)) * 64 + (lane & 3) * 16) = Vc[i];
        if (!(nvalid == 32 && j0 >= 64 * T + 63 && j0 + 31 - 64 * T <= 128)) {
            const int base = (r32 < nvalid) ? (j0 + r32 - 64 * T - 4 * hi) : -100000;
#pragma unroll
            for (int rr = 0; rr < 16; ++rr) { const int c = (rr & 3) + 8 * (rr >> 2);
                if ((unsigned)(base - c) > 128u) s0[rr] = -INFINITY;
                if ((unsigned)(base - c - 32) > 128u) s1[rr] = -INFINITY; }
        }
        float ls = 0.f;
#pragma unroll
        for (int rr = 0; rr < 16; ++rr) { s0[rr] = __builtin_amdgcn_exp2f(s0[rr]); s1[rr] = __builtin_amdgcn_exp2f(s1[rr]); ls += s0[rr] + s1[rr]; }
        lsum += ls;
        bf16x8 pa[4];
        { u32x4 w0, w1, w2, w3;
          w0 = (u32x4){cvtpk(s0[0], s0[1]), cvtpk(s0[2], s0[3]), cvtpk(s0[4], s0[5]), cvtpk(s0[6], s0[7])};
          w1 = (u32x4){cvtpk(s0[8], s0[9]), cvtpk(s0[10], s0[11]), cvtpk(s0[12], s0[13]), cvtpk(s0[14], s0[15])};
          w2 = (u32x4){cvtpk(s1[0], s1[1]), cvtpk(s1[2], s1[3]), cvtpk(s1[4], s1[5]), cvtpk(s1[6], s1[7])};
          w3 = (u32x4){cvtpk(s1[8], s1[9]), cvtpk(s1[10], s1[11]), cvtpk(s1[12], s1[13]), cvtpk(s1[14], s1[15])};
          pa[0] = __builtin_bit_cast(bf16x8, w0); pa[1] = __builtin_bit_cast(bf16x8, w1); pa[2] = __builtin_bit_cast(bf16x8, w2); pa[3] = __builtin_bit_cast(bf16x8, w3); }
#pragma unroll
        for (int dvb = 0; dvb < 2; ++dvb) {
#pragma unroll
            for (int ks = 0; ks < 4; ++ks) { const s16x4 lo = vtr(vt + vrd + dvb * 4096 + ks * 1024), hh = vtr(vt + vrd + dvb * 4096 + ks * 1024 + 512);
                const bf16x8 vf = (bf16x8){lo[0], lo[1], lo[2], lo[3], hh[0], hh[1], hh[2], hh[3]};
                O[dvb] = MIX_MFMA32(pa[ks], vf, O[dvb]); }
        }
        asm volatile("s_waitcnt lgkmcnt(0)" ::: "memory");
        if (item_end && MODE == 3) { asm volatile("" :: "v"(O[0]), "v"(O[1]), "v"(lsum)); }
        if (item_end && MODE != 3) {
            lsum = xor32_sum(lsum);
            { const int prel = r + ((j0 + r32) << sh) - P0;
              if (hi == 0 && r32 < nvalid) Lacc[prel] = (k == 0) ? lsum : (Lacc[prel] + lsum); }
#pragma unroll
            for (int rr = 0; rr < 16; ++rr) { const int row = crow(rr, hi);
                if (row < nvalid) { const int prel = r + ((j0 + row) << sh) - P0;
#pragma unroll
                    for (int dvb = 0; dvb < 2; ++dvb) { LAS float* ap = Oacc + prel * 64 + dvb * 32 + r32; *ap = (k == 0) ? O[dvb][rr] : (*ap + O[dvb][rr]); } } }
            asm volatile("s_waitcnt lgkmcnt(0)" ::: "memory");
            __builtin_amdgcn_s_barrier(); asm volatile("" ::: "memory");
#pragma unroll
            for (int d = 0; d < 2; ++d)
#pragma unroll
                for (int rr = 0; rr < 16; ++rr) O[d][rr] = 0.f;
            lsum = 0.f;
#pragma unroll
            for (int d0 = 0; d0 < 4; ++d0) qr[d0] = qn[d0];
        }
        if (!has_next) break;
        if (MODE != 2) {
#pragma unroll
        for (int i = 0; i < 8; ++i) { Kc[i] = Kn[i]; Vc[i] = Vn[i]; } }
        k = kn; sh = shn; r = rn; j0 = j0n; nvalid = nvn; T0 = T0n; T1 = T1n; T = Tn;
    }
#undef DL_ITEM
#undef DL_LOAD
#undef DL_LOADQ
    asm volatile("s_waitcnt lgkmcnt(0)" ::: "memory");
    __builtin_amdgcn_s_barrier(); asm volatile("" ::: "memory");
    { const int pos = tid >> 1, dh = (tid & 1) * 32;
      const float inv = 1.0f / Lacc[pos];
      bf16_t* yo = ycat + (size_t)(b * NS + P0 + pos) * ND + 768 + h * 64 + dh;
#pragma unroll
      for (int c4 = 0; c4 < 4; ++c4) { const f32x4 a = *(const LAS f32x4*)(Oacc + pos * 64 + dh + c4 * 8), c = *(const LAS f32x4*)(Oacc + pos * 64 + dh + c4 * 8 + 4);
          u32x4 w; w.x = cvtpk(a[0] * inv, a[1] * inv); w.y = cvtpk(a[2] * inv, a[3] * inv); w.z = cvtpk(c[0] * inv, c[1] * inv); w.w = cvtpk(c[2] * inv, c[3] * inv);
          *(u32x4*)(yo + c4 * 8) = w; } }
    asm volatile("s_waitcnt lgkmcnt(0)" ::: "memory");
    __builtin_amdgcn_s_barrier(); asm volatile("" ::: "memory");
}

constexpr int PL_PITCH = 528;
__device__ __forceinline__ void pool_tile(Frame& F, int tile, const bf16_t* Z, bf16_t* ycat, const float* w_pool, const float* b_pool, const float* pool_scale) {
    LAS unsigned char* lds = F.lds;
    const int lane = F.lane, wave = F.wave, r32 = lane & 31, hi = lane >> 5, tid = F.tid;
    const int row0 = tile * 64, pos0 = row0 & (NS - 1);
    {
        LAS unsigned char* ut = lds + 36864;
        const bf16_t* ub = Z + (size_t)(row0 - pos0) * INW + 1536;
#pragma unroll
        for (int i = 0; i < 5; ++i) { const int q = tid + 512 * i, ri = q >> 5, ch = q & 31, p = pos0 - 16 + ri;
            u32x4 v = (u32x4){0u, 0u, 0u, 0u};
            if (p >= 0) v = *(const u32x4*)(ub + (size_t)p * INW + ch * 8);
            *(LAS u32x4*)(ut + ri * 512 + ch * 16) = v; }
        asm volatile("s_waitcnt lgkmcnt(0)" ::: "memory");
        __builtin_amdgcn_s_barrier(); asm volatile("" ::: "memory");
        const int c = tid & 255, th = tid >> 8, g = c >> 6, win = 2 << g;
        const int ps = pos0 + 32 * th;
        const LAS bf16_t* uc = (const LAS bf16_t*)ut + c;
        float sacc = 0.f;
        for (int p = ps - win; p < ps; ++p) sacc += bf2f(uc[(p - pos0 + 16) * 256]);
#pragma unroll 4
        for (int i = 0; i < 32; ++i) {
            const int p = ps + i;
            const float u = bf2f(uc[(p - pos0 + 16) * 256]);
            sacc += u; sacc -= bf2f(uc[(p - win - pos0 + 16) * 256]);
            const float cnt = (float)min(p + 1, win);
            *(LAS bf16_t*)(lds + (32 * th + i) * PL_PITCH + c * 2) = f2bf(sacc / cnt - u);
        }
    }
    asm volatile("s_waitcnt lgkmcnt(0)" ::: "memory");
    __builtin_amdgcn_s_barrier(); asm volatile("" ::: "memory");
    {
        const int g = wave >> 1, mb = wave & 1;
        bf16x8 af[4];
#pragma unroll
        for (int ks = 0; ks < 4; ++ks) af[ks] = *(const LAS bf16x8*)(lds + (32 * mb + r32) * PL_PITCH + (64 * g + 16 * ks + 8 * hi) * 2);
#pragma unroll
        for (int nb = 0; nb < 2; ++nb) {
            f32x16 acc;
#pragma unroll
            for (int rr = 0; rr < 16; ++rr) acc[rr] = 0.f;
            const int e = 32 * nb + r32;
#pragma unroll
            for (int ks = 0; ks < 4; ++ks) {
                const float* wp = w_pool + g * 4096 + (16 * ks + 8 * hi) * 64 + e;
                u32x4 w; w.x = pk2(wp[0], wp[64]); w.y = pk2(wp[128], wp[192]); w.z = pk2(wp[256], wp[320]); w.w = pk2(wp[384], wp[448]);
                acc = MIX_MFMA32(af[ks], __builtin_bit_cast(bf16x8, w), acc);
            }
            const float bb = b_pool[g * 64 + e], ps = pool_scale[g * 64 + e];
            bf16_t* yo = ycat + (size_t)(row0 + 32 * mb) * ND + 512 + 64 * g + e;
#pragma unroll
            for (int rr = 0; rr < 16; ++rr) yo[(size_t)crow(rr, hi) * ND] = f2bf((acc[rr] + bb) * ps);
        }
    }
    asm volatile("s_waitcnt lgkmcnt(0)" ::: "memory");
    __builtin_amdgcn_s_barrier(); asm volatile("" ::: "memory");
}
#undef MIX_MFMA32
}

constexpr int PH_FINAL = 15, PH_END = 16;
#ifndef REP_PHASE
#define REP_PHASE -1
#endif
#ifndef REP_COUNT
#define REP_COUNT 1
#endif
#define NREP(t) ((REP_PHASE == (t)) ? REP_COUNT : 1)
#ifndef DIL_MODE
#define DIL_MODE 0
#endif
__global__ void __launch_bounds__(NWAVES * 64, 2) fwd_kernel(Params P) {
    extern __shared__ __attribute__((aligned(16))) unsigned char lds_raw[];
    Frame F;
    F.lds = (LAS unsigned char*)lds_raw;
    F.tid = threadIdx.x; F.lane = F.tid & 63; F.wave = __builtin_amdgcn_readfirstlane(F.tid >> 6);
    F.G = gridDim.x; { const int bx = blockIdx.x; F.vcu = (F.G % 8 == 0) ? (bx % 8) * (F.G / 8) + bx / 8 : bx; }
    F.in = P.in; F.out = P.out; F.ws = P.ws;
    volatile LAS unsigned* MISC = (volatile LAS unsigned*)(F.lds + MISC_OFF);
    if (F.tid < 64) MISC[F.tid] = 0u;
    __syncthreads();
    unsigned* ctl = (unsigned*)(P.ws + WS_CTL);
    const int lo = P.ph_lo, hi = P.ph_hi;
    const bool multi = (hi - lo) > 1;
    XcdBarrier bar; bar.bar = ctl + CW_BAR; bar.x = 0; bar.st = nullptr;
    if (multi) bar = xcd_barrier_post(ctl + CW_BAR, MISC + 8);
#ifdef ONLY_PHASE
#define IN(k) ((((k) == 0 || (k) == PH_FINAL) ? (k) : (((k) - 1) % 7 + 1)) == ONLY_PHASE && lo <= (k) && (k) < hi)
#else
#define IN(k) (lo <= (k) && (k) < hi)
#endif
#ifdef STATS
    unsigned long long st_t = __builtin_amdgcn_s_memrealtime();
#define ST_BODY(k) do { if (threadIdx.x == 0) { const unsigned long long n_ = __builtin_amdgcn_s_memrealtime(); const unsigned d_ = (unsigned)(n_ - st_t); st_t = n_; \
        ctl[CW_STAT + ((k) * 2) * 256 + blockIdx.x] = d_; } } while (0)
#define ST_WAIT(k) do { if (threadIdx.x == 0) { const unsigned long long n_ = __builtin_amdgcn_s_memrealtime(); const unsigned d_ = (unsigned)(n_ - st_t); st_t = n_; \
        ctl[CW_STAT + ((k) * 2 + 1) * 256 + blockIdx.x] = d_; } } while (0)
#else
#define ST_BODY(k) do {} while (0)
#define ST_WAIT(k) do {} while (0)
#endif
#define SEAM(k) do { ST_BODY(k); if (IN(k) && IN((k) + 1)) { for (int rb_ = 0; rb_ < NREP(9); ++rb_) xcd_barrier(bar); } ST_WAIT(k); } while (0)
#define FRESH() do { int t_ = threadIdx.x; asm volatile("" : "+v"(t_)); F.tid = t_; F.lane = t_ & 63; F.wave = __builtin_amdgcn_readfirstlane(t_ >> 6); \
        unsigned char* w_ = P.ws; asm volatile("" : "+s"(w_)); F.ws = w_; mod = (float*)(w_ + WS_MOD); HB = (bf16_t*)(w_ + WS_HB); ZB = (bf16_t*)(w_ + WS_ZB); YM = ZB; } while (0)
    float* mod; bf16_t *HB, *ZB, *YM;

    if (IN(0)) { for (int rep_ = 0; rep_ < NREP(0); ++rep_) { FRESH(); p0_prologue(F); } }
    SEAM(0);
    for (int l = 0; l < NL; ++l) {
        const int base = 1 + 7 * l;
        if (IN(base + 0)) { FRESH(); const float* modl = mod + (size_t)l * NB * NMOD;
            if (l == 0) for (int rep_ = 0; rep_ < NREP(1); ++rep_) ln_rows<0, 1>(F, P.in[I_X], nullptr, nullptr, nullptr, P.in[I_GN1] + l * ND, modl, 0, 1024, HB);
            else {
                for (int rep_ = 1; rep_ < NREP(10); ++rep_) { FRESH(); ln_rows<1, 1>(F, P.out, (float*)(F.ws + WS_END), YM, mod + (size_t)(l - 1) * NB * NMOD + 5120, P.in[I_GN1] + l * ND, mod + (size_t)l * NB * NMOD, 0, 1024, HB); }
                ln_rows<1, 1>(F, P.out, P.out, YM, mod + (size_t)(l - 1) * NB * NMOD + 5120, P.in[I_GN1] + l * ND, modl, 0, 1024, HB);
            }
        }
        SEAM(base + 0);
        if (IN(base + 1)) { FRESH();
            pg8::Gemm g{HB, (const bf16_t*)(F.ws + WS_WIN) + (size_t)l * INW * ND, ND};
            pg8::StaticOrder S; S.init(NT, INW, F.G, (int)blockIdx.x);
            pg8::EpiInProj E{ZB, (const float*)(F.ws + WS_GAINS) + l * 256, (const float*)(F.ws + WS_COS), (const float*)(F.ws + WS_SIN)};
            for (int rep_ = 0; rep_ < NREP(2); ++rep_) { FRESH(); pg8::gemm_phase<pg8::EpiInProj, pg8::StaticOrder, true, false>(F.lds, F.tid, g, S, E); }
        }
        SEAM(base + 1);
        if (IN(base + 2)) { FRESH();
            const float* lamv = (const float*)(F.ws + WS_LAM);
            const float lam = lamv[2 * l], omli = 1.0f - lamv[2 * l + 1], negCb = -lamv[16 + 2 * l];
            for (int rep_ = 1; rep_ < NREP(30); ++rep_)
            for (int u = F.vcu; u < NB * 4 * 8; u += F.G) { FRESH();
                mix::da_unit<DIL_MODE>(F, u >> 5, (u >> 3) & 3, u & 7, ZB, HB, lam, omli, negCb, P.in[I_GSUBA] + l * 128); }
            for (int u = F.vcu; u < NB * 4 * 8; u += F.G) { FRESH();
                mix::da_unit<0>(F, u >> 5, (u >> 3) & 3, u & 7, ZB, HB, lam, omli, negCb, P.in[I_GSUBA] + l * 128); }
            { const float negCc = -lamv[16 + 2 * l + 1];
              for (int rep_ = 1; rep_ < NREP(31); ++rep_) for (int u = F.vcu; u < NB * 4 * 8; u += F.G) { FRESH(); mix::dil_span<DIL_MODE>(F, u >> 5, (u >> 3) & 3, u & 7, ZB, HB, negCc); }
              for (int u = F.vcu; u < NB * 4 * 8; u += F.G) { FRESH(); mix::dil_span<0>(F, u >> 5, (u >> 3) & 3, u & 7, ZB, HB, negCc); } }
            for (int rep_ = 0; rep_ < NREP(32); ++rep_) for (int u = F.vcu; u < NT / 64; u += F.G) { FRESH(); mix::pool_tile(F, u, ZB, HB, P.in[I_WPOOL] + l * 16384, P.in[I_BPOOL] + l * 256, P.in[I_PSCALE] + l * 256); }
        }
        SEAM(base + 2);
        if (IN(base + 3)) { FRESH();
            pg8::Gemm g{HB, (const bf16_t*)(F.ws + WS_WOUT) + (size_t)l * ND * ND, ND};
            pg8::StaticOrder S; S.init(NT, ND, F.G, (int)blockIdx.x);
            pg8::EpiResid E{(l == 0) ? P.in[I_X] : P.out, P.out, mod + (size_t)l * NB * NMOD + 2048};
            for (int rep_ = 0; rep_ < ((l == 0) ? NREP(4) : 1); ++rep_) { FRESH(); pg8::gemm_phase<pg8::EpiResid, pg8::StaticOrder, false, false>(F.lds, F.tid, g, S, E); }
        }
        SEAM(base + 3);
        if (IN(base + 4)) {
            for (int rep_ = 1; rep_ < NREP(5); ++rep_) { FRESH(); router_phase<DIL_MODE>(F, l, 2 + rep_, P.out, mod + (size_t)l * NB * NMOD, HB); }
            FRESH(); router_phase<0>(F, l, l, P.out, mod + (size_t)l * NB * NMOD, HB); }
        SEAM(base + 4);
        if (IN(base + 5)) { FRESH();
            for (int rep_ = 0; rep_ < NREP(6); ++rep_)
            for (int first = 0;; first += 4) { FRESH();
                const int nl = build_group_tables(F, l, 2, first, true);
                if (nl == 0) break;
                pg8::GroupedOrder S{(const LAS int*)(F.lds + TAB_OFF), (const LAS unsigned*)(F.lds + TAB_ROWS_OFF), nl};
                pg8::Gemm g{HB, (const bf16_t*)(F.ws + WS_WUP) + (size_t)l * NEXP * 512 * ND, ND};
                pg8::EpiSwiGLU E{(bf16_t*)(F.ws + WS_HID)};
                pg8::gemm_phase<pg8::EpiSwiGLU, pg8::GroupedOrder, false, true>(F.lds, F.tid, g, S, E);
                if (nl < 4) break;
            }
        }
        SEAM(base + 5);
        if (IN(base + 6)) { FRESH();
            for (int rep_ = 0; rep_ < NREP(7); ++rep_)
            for (int first = 0;; first += 4) { FRESH();
                const int nl = build_group_tables(F, l, 4, first, false);
                if (nl == 0) break;
                pg8::GroupedOrder S{(const LAS int*)(F.lds + TAB_OFF), nullptr, nl};
                pg8::Gemm g{(const bf16_t*)(F.ws + WS_HID), (const bf16_t*)(F.ws + WS_WDN) + (size_t)l * NEXP * ND * NF, NF};
                pg8::EpiScatter E{YM, (const LAS int*)(F.lds + TAB_ROWS_OFF), (const LAS float*)(F.lds + TAB_ROWS2_OFF)};
                pg8::gemm_phase<pg8::EpiScatter, pg8::GroupedOrder, false, false>(F.lds, F.tid, g, S, E);
                if (nl < 4) break;
            }
        }
        SEAM(base + 6);
    }
#ifdef STATS
    unsigned long long spin_ticks = 0;
    if (blockIdx.x == 0) {
        LAS unsigned* sacc = (LAS unsigned*)(F.lds + TAB_OFF);
        if (threadIdx.x < 64) sacc[threadIdx.x] = 0u;
        __syncthreads();
        if (threadIdx.x < 256) for (int k = 0; k < 15; ++k) {
            const unsigned bd = __hip_atomic_load(ctl + CW_STAT + (k * 2) * 256 + threadIdx.x, RLX_AGENT), wt = __hip_atomic_load(ctl + CW_STAT + (k * 2 + 1) * 256 + threadIdx.x, RLX_AGENT);
            atomicAdd((unsigned*)(sacc + k * 4), bd); atomicMax((unsigned*)(sacc + k * 4 + 1), bd); atomicAdd((unsigned*)(sacc + k * 4 + 2), wt); atomicMax((unsigned*)(sacc + k * 4 + 3), wt);
        }
        __syncthreads();
        if (threadIdx.x == 0) {
            unsigned long long qa = 0, qb = 0;
            for (int k = 0; k < 15; ++k) {
                const int t = (k == 0) ? 0 : ((k - 1) % 7 + 1);
                const unsigned vals[4] = {sacc[k * 4] / (unsigned)F.G, sacc[k * 4 + 1], sacc[k * 4 + 2] / (unsigned)F.G, sacc[k * 4 + 3]};
                if (STAT_TA < 0 || STAT_TA == t) qa += vals[STAT_MA];
                if (STAT_TB < 0 || STAT_TB == t) qb += vals[STAT_MB];
            }
            spin_ticks = qa + 200000ull * ((qb + 500) / 1000);
        }
        __syncthreads();
    }
#endif
    if (IN(PH_FINAL)) { for (int rep_ = 1; rep_ < NREP(8); ++rep_) { FRESH(); ln_rows<1, 0>(F, P.out, (float*)(F.ws + WS_END), YM, mod + (size_t)(NL - 1) * NB * NMOD + 5120, nullptr, nullptr, 0, 0, nullptr); } }
    if (IN(PH_FINAL)) { FRESH(); ln_rows<1, 0>(F, P.out, P.out, YM, mod + (size_t)(NL - 1) * NB * NMOD + 5120, nullptr, nullptr, 0, 0, nullptr); }
#ifdef STATS
    if (blockIdx.x == 0 && threadIdx.x == 0) { const unsigned long long t0_ = __builtin_amdgcn_s_memrealtime(); while (__builtin_amdgcn_s_memrealtime() - t0_ < spin_ticks) __builtin_amdgcn_s_sleep(8); }
#endif
#undef IN
#undef SEAM
}

static void launch_phases(const Params& base, int lo, int hi, int grid, hipStream_t stream) {
    Params p = base; p.ph_lo = lo; p.ph_hi = hi;
    hipLaunchKernelGGL(fwd_kernel, dim3(grid), dim3(NWAVES * 64), LDS_BYTES, stream, p);
}

extern "C" void kernel_launch(void* const* d_in, const int* in_sizes, int n_in, void* d_out, int out_size, void* d_ws, size_t ws_size, hipStream_t stream) {
    static int grid = 0;
    if (grid == 0) {
        int dev = 0, cus = 0;
        hipGetDevice(&dev);
        hipDeviceGetAttribute(&cus, hipDeviceAttributeMultiprocessorCount, dev);
        hipFuncSetAttribute((const void*)fwd_kernel, hipFuncAttributeMaxDynamicSharedMemorySize, LDS_BYTES);
        (void)hipGetLastError();
        grid = cus > 0 ? cus : 256;
    }
    hipMemsetAsync((char*)d_ws + WS_CTL, 0, CTL_ZERO_BYTES, stream);
    Params P{};
    for (int i = 0; i < 24; ++i) P.in[i] = (const float*)d_in[i];
    P.out = (float*)d_out; P.ws = (unsigned char*)d_ws;

#ifdef MULTI_LAUNCH
    for (int ph = 0; ph < PH_END; ++ph) launch_phases(P, ph, ph + 1, grid, stream);
#else
    launch_phases(P, 0, PH_END, grid, stream);
#endif
}
```
